# Optimizing an MI355X kernel written in HIP

```python
import jax, jax.numpy as jnp
from jax import lax
import numpy as np

D_MODEL = 1024
BATCH = 16
SEQ = 256
DEPTH = 1
DEC_BATCH = 4
DEC_SEQ = 4096
PAST_LEN = 256

GRID_W = 64
H_A = 8
DK_A = 128
DV_A = 128
D_QK = H_A * DK_A
D_VA = H_A * DV_A
CHUNK = 64
CONV_K = 4
CONV_PAD_L = 2
D_B = 1024
NB_B = 8
BW_B = D_B // NB_B
LRU_C = 8.0
EPS = 1e-6
OFF_QKV = 2 * D_QK + D_VA
OFF_ZA = OFF_QKV + D_VA
OFF_XB = OFF_ZA + D_B
OFF_ZB = OFF_XB + D_B
IN_COLS = OFF_ZB + 4 * H_A

kernel_name = 'hybrid_gdn_rglru_prefix_diffusion_step'


def rmsnorm(x, w):
    xf = x.astype(jnp.float32)
    y = xf * lax.rsqrt(jnp.mean(xf * xf, axis=-1, keepdims=True) + EPS)
    return (y * w.astype(jnp.float32)).astype(x.dtype)


def l2norm(x):
    xf = x.astype(jnp.float32)
    return xf * lax.rsqrt(jnp.sum(xf * xf, axis=-1, keepdims=True) + EPS)


def dwconv_centred(x, w, b):
    n = x.shape[1]
    xp = jnp.pad(x, ((0, 0), (CONV_PAD_L, CONV_K - 1 - CONV_PAD_L), (0, 0)))
    y = xp[:, 0:n] * w[0]
    for i in range(1, CONV_K):
        y = y + xp[:, i:i + n] * w[i]
    return y + b


def delta_rule_chunked(q, k, v, g, beta, s0):
    b, h, n, dk = q.shape
    dv = v.shape[-1]
    nc = n // CHUNK
    f32 = jnp.float32
    q = (q.astype(f32) * (dk ** -0.5)).reshape(b, h, nc, CHUNK, dk)
    k = k.astype(f32).reshape(b, h, nc, CHUNK, dk)
    v = v.astype(f32).reshape(b, h, nc, CHUNK, dv)
    g = jnp.cumsum(g.astype(f32).reshape(b, h, nc, CHUNK), axis=-1)
    beta = beta.astype(f32).reshape(b, h, nc, CHUNK, 1)
    idx = jnp.arange(CHUNK)
    incl = idx[:, None] >= idx[None, :]
    strict = idx[:, None] > idx[None, :]
    decay = jnp.exp(jnp.where(incl, g[..., :, None] - g[..., None, :], -jnp.inf))
    kb = k * beta
    a_mat = jnp.where(strict, jnp.einsum('bhnik,bhnjk->bhnij', kb, k) * decay, 0.0)
    lower = a_mat + jnp.eye(CHUNK, dtype=f32)
    rhs = jnp.concatenate([v * beta, kb * jnp.exp(g)[..., None]], axis=-1)
    sol = lax.linalg.triangular_solve(lower, rhs, left_side=True, lower=True, unit_diagonal=True)
    u, w = sol[..., :dv], sol[..., dv:]
    qk = jnp.einsum('bhnik,bhnjk->bhnij', q, k) * decay
    qg = q * jnp.exp(g)[..., None]
    g_last = g[..., -1]
    kd = k * jnp.exp(g_last[..., None] - g)[..., None]
    decay_last = jnp.exp(g_last)

    def step(s, xs):
        w_c, u_c, qg_c, qk_c, kd_c, dl_c = xs
        v_new = u_c - jnp.einsum('bhck,bhkv->bhcv', w_c, s)
        o_c = jnp.einsum('bhck,bhkv->bhcv', qg_c, s) + jnp.einsum('bhcj,bhjv->bhcv', qk_c, v_new)
        s = s * dl_c[..., None, None] + jnp.einsum('bhck,bhcv->bhkv', kd_c, v_new)
        return s, o_c

    xs = tuple(jnp.moveaxis(t, 2, 0) for t in (w, u, qg, qk, kd, decay_last))
    s_fin, o = lax.scan(step, s0.astype(f32), xs)
    o = jnp.moveaxis(o, 0, 2).reshape(b, h, n, dv)
    return o, s_fin


def gdn_branch(qkv, z, gate_cols, p, s_f, s_b):
    bsz, n, _ = qkv.shape
    qkv = jax.nn.silu(dwconv_centred(qkv, p['conv_a_w'], p['conv_a_b']))
    q, k, v = jnp.split(qkv, [D_QK, 2 * D_QK], axis=-1)
    heads = lambda t, d: t.reshape(bsz, n, H_A, d).transpose(0, 2, 1, 3)
    q = l2norm(heads(q, DK_A))
    k = l2norm(heads(k, DK_A))
    v = heads(v, DV_A)
    alpha_f, beta_f, alpha_b, beta_b = jnp.split(gate_cols.astype(jnp.float32), 4, axis=-1)

    def gates(a, bt, a_log, dt_bias):
        g = -jnp.exp(a_log.astype(jnp.float32)) * jax.nn.softplus(a + dt_bias.astype(jnp.float32))
        return g.transpose(0, 2, 1), jax.nn.sigmoid(bt).transpose(0, 2, 1)

    g_f, bet_f = gates(alpha_f, beta_f, p['a_log_fwd'], p['dt_bias_fwd'])
    g_b, bet_b = gates(alpha_b, beta_b, p['a_log_bwd'], p['dt_bias_bwd'])
    o_f, sf_new = delta_rule_chunked(q, k, v, g_f, bet_f, s_f)
    flip = lambda t: jnp.flip(t, axis=2)
    o_b, sb_new = delta_rule_chunked(flip(q), flip(k), flip(v), flip(g_b), flip(bet_b), s_b)
    o = rmsnorm(o_f + flip(o_b), p['onorm_a_w'])
    o = o.transpose(0, 2, 1, 3).reshape(bsz, n, D_VA).astype(z.dtype)
    return o * jax.nn.silu(z), sf_new, sb_new


def blockdiag(x, w, b):
    bsz, n, _ = x.shape
    y = jnp.einsum('bnhi,hij->bnhj', x.reshape(bsz, n, NB_B, BW_B), w).reshape(bsz, n, D_B)
    return y + b


def rglru(x, wa, ba, wx, bx, lam, h0):
    f32 = jnp.float32
    xf = x.astype(f32)
    r = jax.nn.sigmoid(blockdiag(xf, wa.astype(f32), ba.astype(f32)))
    ig = jax.nn.sigmoid(blockdiag(xf, wx.astype(f32), bx.astype(f32)))
    log_a = -LRU_C * r * jax.nn.softplus(-lam.astype(f32))
    a = jnp.exp(log_a)
    bx_t = jnp.sqrt(-jnp.expm1(2.0 * log_a)) * (ig * xf)
    bx_t = bx_t.at[:, 0].add(a[:, 0] * h0.astype(f32))

    def comb(left, right):
        a_l, b_l = left
        a_r, b_r = right
        return a_l * a_r, a_r * b_l + b_r

    _, hs = lax.associative_scan(comb, (a, bx_t), axis=1)
    return hs, hs[:, -1]


def lru_branch(xb, z, p, h_f, h_b, col_major):
    bsz, n, _ = xb.shape
    if col_major:
        rows = n // GRID_W
        to_order = lambda t: t.reshape(bsz, rows, GRID_W, -1).transpose(0, 2, 1, 3).reshape(bsz, n, -1)
        from_order = lambda t: t.reshape(bsz, GRID_W, rows, -1).transpose(0, 2, 1, 3).reshape(bsz, n, -1)
    else:
        to_order = lambda t: t
        from_order = lambda t: t
    xc = dwconv_centred(to_order(xb), p['conv_b_w'], p['conv_b_b'])
    hf, hf_last = rglru(xc, p['lru_wa_fwd'], p['lru_ba_fwd'], p['lru_wx_fwd'], p['lru_bx_fwd'],
                       p['lru_lambda_fwd'], h_f)
    hb, hb_last = rglru(jnp.flip(xc, axis=1), p['lru_wa_bwd'], p['lru_ba_bwd'], p['lru_wx_bwd'],
                        p['lru_bx_bwd'], p['lru_lambda_bwd'], h_b)
    hsum = from_order(hf + jnp.flip(hb, axis=1)).astype(z.dtype)
    return hsum * jax.nn.silu(z), hf_last, hb_last


def trunk_layer(x, mod, s_af, s_ab, s_bf, s_bb, col_major, p):
    shift, scale, gate = jnp.split(mod, 3, axis=-1)
    h = rmsnorm(x, p['norm_w']) * (1 + scale) + shift
    proj = h @ p['w_in']
    qkv, z_a, x_b, z_b, gate_cols = jnp.split(proj, [OFF_QKV, OFF_ZA, OFF_XB, OFF_ZB], axis=-1)
    o_a, sfa, sba = gdn_branch(qkv, z_a, gate_cols, p, s_af, s_ab)
    o_b, sfb, sbb = lru_branch(x_b, z_b, p, s_bf, s_bb, col_major)
    pa = o_a @ p['w_proj_a']
    pb = o_b @ p['w_proj_b']
    g_a, g_b = jnp.split(jax.nn.sigmoid(h @ p['w_gate'] + p['b_gate']), 2, axis=-1)
    mixed = (g_a * pa + g_b * pb) @ p['w_out']
    return x + gate * mixed, sfa, sba, sfb, sbb


def setup_inputs(seed: int = 0) -> dict:
    key = jax.random.key(seed)
    ks = iter(jax.random.split(key, 64))
    nk = lambda: next(ks)
    nrm = lambda shape, s: jax.random.normal(nk(), shape, jnp.float32) * s
    L = DEPTH
    dt = jnp.exp(jax.random.uniform(nk(), (L, H_A), jnp.float32, np.log(1e-3), np.log(1e-1)))
    dt2 = jnp.exp(jax.random.uniform(nk(), (L, H_A), jnp.float32, np.log(1e-3), np.log(1e-1)))
    inv_sp = lambda d: d + jnp.log(-jnp.expm1(-d))
    a0 = jax.random.uniform(nk(), (L, D_B), jnp.float32, 0.9, 0.999)
    a1 = jax.random.uniform(nk(), (L, D_B), jnp.float32, 0.9, 0.999)
    logit = lambda a: jnp.log(a) - jnp.log1p(-a)
    return {
        'x_prompt': nrm((BATCH, SEQ, D_MODEL), 1.0),
        'x_sample': nrm((DEC_BATCH, DEC_SEQ, D_MODEL), 1.0),
        'state_a_fwd': nrm((DEC_BATCH, DEPTH, H_A, DK_A, DV_A), 0.5),
        'state_a_bwd': nrm((DEC_BATCH, DEPTH, H_A, DK_A, DV_A), 0.5),
        'state_b_fwd': nrm((DEC_BATCH, DEPTH, D_B), 0.5),
        'state_b_bwd': nrm((DEC_BATCH, DEPTH, D_B), 0.5),
        'c': nrm((DEC_BATCH, D_MODEL), 1.0),
        'c_ctx': nrm((D_MODEL,), 1.0),
        'norm_w': 1.0 + nrm((L, D_MODEL), 0.02),
        'w_mod': nrm((L, D_MODEL, 3 * D_MODEL), 0.5 * D_MODEL ** -0.5),
        'b_mod': nrm((L, 3 * D_MODEL), 0.01),
        'w_in': nrm((L, D_MODEL, IN_COLS), D_MODEL ** -0.5),
        'conv_a_w': nrm((L, CONV_K, OFF_QKV), CONV_K ** -0.5),
        'conv_a_b': nrm((L, OFF_QKV), 0.01),
        'a_log_fwd': jnp.log(jax.random.uniform(nk(), (L, H_A), jnp.float32, 1.0, 16.0)),
        'dt_bias_fwd': inv_sp(dt),
        'a_log_bwd': jnp.log(jax.random.uniform(nk(), (L, H_A), jnp.float32, 1.0, 16.0)),
        'dt_bias_bwd': inv_sp(dt2),
        'onorm_a_w': 1.0 + nrm((L, DV_A), 0.02),
        'conv_b_w': nrm((L, CONV_K, D_B), CONV_K ** -0.5),
        'conv_b_b': nrm((L, D_B), 0.01),
        'lru_wa_fwd': nrm((L, NB_B, BW_B, BW_B), BW_B ** -0.5),
        'lru_ba_fwd': nrm((L, D_B), 0.01),
        'lru_wx_fwd': nrm((L, NB_B, BW_B, BW_B), BW_B ** -0.5),
        'lru_bx_fwd': nrm((L, D_B), 0.01),
        'lru_lambda_fwd': logit(a0),
        'lru_wa_bwd': nrm((L, NB_B, BW_B, BW_B), BW_B ** -0.5),
        'lru_ba_bwd': nrm((L, D_B), 0.01),
        'lru_wx_bwd': nrm((L, NB_B, BW_B, BW_B), BW_B ** -0.5),
        'lru_bx_bwd': nrm((L, D_B), 0.01),
        'lru_lambda_bwd': logit(a1),
        'w_proj_a': nrm((L, D_VA, D_MODEL), D_VA ** -0.5),
        'w_proj_b': nrm((L, D_B, D_MODEL), D_B ** -0.5),
        'w_gate': nrm((L, D_MODEL, 2 * D_MODEL), D_MODEL ** -0.5),
        'b_gate': nrm((L, 2 * D_MODEL), 0.01),
        'w_out': nrm((L, D_MODEL, D_MODEL), D_MODEL ** -0.5),
        'final_norm_w': 1.0 + nrm((D_MODEL,), 0.02),
    }


def reference(x_prompt, x_sample, state_a_fwd, state_a_bwd, state_b_fwd, state_b_bwd, c, c_ctx,
              norm_w, w_mod, b_mod, w_in, conv_a_w, conv_a_b, a_log_fwd, dt_bias_fwd, a_log_bwd,
              dt_bias_bwd, onorm_a_w, conv_b_w, conv_b_b, lru_wa_fwd, lru_ba_fwd, lru_wx_fwd,
              lru_bx_fwd, lru_lambda_fwd, lru_wa_bwd, lru_ba_bwd, lru_wx_bwd, lru_bx_bwd,
              lru_lambda_bwd, w_proj_a, w_proj_b, w_gate, b_gate, w_out, final_norm_w):
    bp = x_prompt.shape[0]
    xp, xs = x_prompt, x_sample
    new_af, new_ab, new_bf, new_bb = [], [], [], []
    for l in range(DEPTH):
        p = {
            'norm_w': norm_w[l], 'w_in': w_in[l], 'conv_a_w': conv_a_w[l], 'conv_a_b': conv_a_b[l],
            'a_log_fwd': a_log_fwd[l], 'dt_bias_fwd': dt_bias_fwd[l],
            'a_log_bwd': a_log_bwd[l], 'dt_bias_bwd': dt_bias_bwd[l], 'onorm_a_w': onorm_a_w[l],
            'conv_b_w': conv_b_w[l], 'conv_b_b': conv_b_b[l],
            'lru_wa_fwd': lru_wa_fwd[l], 'lru_ba_fwd': lru_ba_fwd[l], 'lru_wx_fwd': lru_wx_fwd[l],
            'lru_bx_fwd': lru_bx_fwd[l], 'lru_lambda_fwd': lru_lambda_fwd[l],
            'lru_wa_bwd': lru_wa_bwd[l], 'lru_ba_bwd': lru_ba_bwd[l], 'lru_wx_bwd': lru_wx_bwd[l],
            'lru_bx_bwd': lru_bx_bwd[l], 'lru_lambda_bwd': lru_lambda_bwd[l],
            'w_proj_a': w_proj_a[l], 'w_proj_b': w_proj_b[l], 'w_gate': w_gate[l],
            'b_gate': b_gate[l], 'w_out': w_out[l],
        }
        mod_ctx = (jax.nn.silu(c_ctx) @ w_mod[l] + b_mod[l])[None, None, :]
        mod_lat = (jax.nn.silu(c) @ w_mod[l] + b_mod[l])[:, None, :]
        za = jnp.zeros((bp, H_A, DK_A, DV_A), jnp.float32)
        zb = jnp.zeros((bp, D_B), jnp.float32)
        xp, saf, sab, sbf, sbb = trunk_layer(xp, mod_ctx, za, za, zb, zb, False, p)
        new_af.append(saf.astype(x_prompt.dtype))
        new_ab.append(sab.astype(x_prompt.dtype))
        new_bf.append(sbf.astype(x_prompt.dtype))
        new_bb.append(sbb.astype(x_prompt.dtype))
        xs, _, _, _, _ = trunk_layer(xs, mod_lat, state_a_fwd[:, l], state_a_bwd[:, l],
                                     state_b_fwd[:, l], state_b_bwd[:, l], True, p)
    y_prompt = rmsnorm(xp, final_norm_w)
    y_sample = rmsnorm(xs, final_norm_w)
    new_state_a_fwd = jnp.stack(new_af, axis=1)
    new_state_a_bwd = jnp.stack(new_ab, axis=1)
    new_state_b_fwd = jnp.stack(new_bf, axis=1)
    new_state_b_bwd = jnp.stack(new_bb, axis=1)
    return (y_prompt, y_sample, new_state_a_fwd, new_state_a_bwd, new_state_b_fwd, new_state_b_bwd)
```

```cpp
#include <hip/hip_runtime.h>
#include <hip/hip_bf16.h>
#include <hip/hip_cooperative_groups.h>
#include <cstdio>
namespace cg = cooperative_groups;

using bf16 = __hip_bfloat16;
using bf16x8 = __attribute__((ext_vector_type(8))) short;
using f32x4 = __attribute__((ext_vector_type(4))) float;
typedef unsigned short us;

constexpr int DM = 1024;
constexpr int NTOK = 20480;
constexpr int NG = 4;
constexpr int GR = 5120;
constexpr int NA = 4352;
constexpr int NB1 = 4096;
constexpr int OUT_SAF = 20971520, OUT_SAB = 23068672, OUT_SBF = 25165824, OUT_SBB = 25182208;

constexpr size_t WS_WA = 0;
constexpr size_t WS_WB = WS_WA + (size_t)NA * 1024 * 2;
constexpr size_t WS_WPA = WS_WB + (size_t)NB1 * 1024 * 2;
constexpr size_t WS_WPB = WS_WPA + 4194304;
constexpr size_t WS_WOUT = WS_WPB + 4194304;
constexpr size_t WS_WL = WS_WOUT + 4194304;
constexpr size_t WS_MOD = WS_WL + 1048576;
constexpr size_t WS_OCAT = WS_MOD + 65536;
constexpr size_t WS_BIG = WS_OCAT + (size_t)NTOK * 2048 * 2;
constexpr size_t WS_QKV = WS_BIG;
constexpr size_t WS_XB = WS_QKV + (size_t)GR * 3072 * 2;
constexpr size_t WS_GC = WS_XB + (size_t)GR * 1024 * 2;
constexpr size_t WS_AGG = WS_GC + (size_t)GR * 32 * 4;
constexpr size_t WS_Q = WS_AGG + (size_t)80 * 4 * 1024 * 4;
constexpr size_t WS_KT = WS_Q + (size_t)640 * 8192 * 2;
constexpr size_t WS_WN = WS_KT + (size_t)640 * 8192 * 2;
constexpr size_t WS_U = WS_WN + (size_t)1280 * 8192 * 2;
constexpr size_t WS_QKM = WS_U + (size_t)1280 * 8192 * 2;
constexpr size_t WS_EG = WS_QKM + (size_t)1280 * 4096 * 2;
constexpr size_t WS_ES = WS_EG + (size_t)1280 * 64 * 4;
constexpr size_t WS_DL = WS_ES + (size_t)1280 * 64 * 4;
constexpr size_t WS_GEND = WS_DL + 8192;
constexpr size_t WS_GATE = WS_BIG;
constexpr size_t WS_END = WS_GATE + (size_t)NTOK * 2048 * 2;
static_assert(WS_GEND <= 268435456ull, "group region too large");
static_assert(WS_END <= 268435456ull, "workspace too large");

constexpr int LDS_BYTES = 147456;

struct Params {
  const float* in[37];
  float* out;
  char* ws;
};

extern __shared__ __attribute__((aligned(16))) bf16 shm[];

__device__ __forceinline__ us f2bf(float f) {
  unsigned u = __float_as_uint(f);
  u += 0x7fffu + ((u >> 16) & 1u);
  return (us)(u >> 16);
}
__device__ __forceinline__ float bf2f(us b) { return __uint_as_float(((unsigned)b) << 16); }
__device__ __forceinline__ float sigmoidf_(float x) { return 1.f / (1.f + __expf(-x)); }
__device__ __forceinline__ float siluf_(float x) { return x / (1.f + __expf(-x)); }
__device__ __forceinline__ float softplusf_(float x) { return x > 20.f ? x : log1pf(__expf(x)); }
__device__ __forceinline__ unsigned pack2(float a, float b) { return (unsigned)f2bf(a) | ((unsigned)f2bf(b) << 16); }

__device__ __forceinline__ int tid_l() {
  int t = threadIdx.x;
  asm volatile("" : "+v"(t));
  return t;
}

__device__ __forceinline__ int grow(int g, int r) {
  return r < 1024 ? g * 1024 + r : 4096 + g * 4096 + (r - 1024);
}
__device__ __forceinline__ const float* xrow(const Params& p, int R) {
  return R < 4096 ? p.in[0] + (size_t)R * 1024 : p.in[1] + (size_t)(R - 4096) * 1024;
}
__device__ __forceinline__ int modidx(int R) { return R < 4096 ? 0 : 1 + ((R - 4096) >> 12); }

constexpr int BK = 64, HALF = 128, HT = HALF * BK;
__device__ __forceinline__ int lds_byte(int r, int c) {
  int st = (r >> 4) * 2 + (c >> 5), rr = r & 15, cc = c & 31, ob = rr * 64 + cc * 2;
  return st * 1024 + (ob ^ (((ob >> 9) & 1) << 5));
}
__device__ __forceinline__ void stage_rc(int b, int& R, int& C) {
  int st = b / 1024, sb = b % 1024, swz = sb ^ (((sb >> 9) & 1) << 5);
  R = (st >> 1) * 16 + swz / 64;
  C = (st & 1) * 32 + (swz % 64) / 2;
}

__device__ __forceinline__ void gemm_tile(const bf16* __restrict__ A, int lda, const bf16* __restrict__ Bt, int ldb, int K,
                                          f32x4 (&acc)[2][2][4][2]) {
#define SA(b, h) (shm + ((b)*2 + (h)) * HT)
#define SB(b, h) (shm + (4 + (b)*2 + (h)) * HT)
#define STAGE(P, BASE, LD, br, kt)                                                                       \
  do {                                                                                                   \
    const bf16* _gb = (BASE) + ((long)(br) * (LD) + (long)(kt)*BK);                                      \
    const int _o0 = ((LD) == lda) ? oa0 : ob0, _o1 = ((LD) == lda) ? oa1 : ob1;                          \
    __builtin_amdgcn_global_load_lds((const unsigned*)(_gb + _o0), (unsigned*)((char*)(P) + lb0), 16, 0, 0); \
    __builtin_amdgcn_global_load_lds((const unsigned*)(_gb + _o1), (unsigned*)((char*)(P) + lb0 + 8192), 16, 0, 0); \
  } while (0)
#define LDA(dst, b, h)                                                                                   \
  _Pragma("unroll") for (int m = 0; m < 4; ++m)                                                          \
    _Pragma("unroll") for (int k = 0; k < 2; ++k)                                                        \
  dst[m][k] = *reinterpret_cast<const bf16x8*>((char*)SA(b, h) + lds_byte(wr * 64 + m * 16 + fr, k * 32 + fq * 8))
#define LDB(dst, b, h)                                                                                   \
  _Pragma("unroll") for (int n = 0; n < 2; ++n)                                                          \
    _Pragma("unroll") for (int k = 0; k < 2; ++k)                                                        \
  dst[n][k] = *reinterpret_cast<const bf16x8*>((char*)SB(b, h) + lds_byte(wc * 32 + n * 16 + fr, k * 32 + fq * 8))
#define MMA(ai, bj, At, Bt_)                                                                             \
  do {                                                                                                   \
    __builtin_amdgcn_s_setprio(1);                                                                       \
    _Pragma("unroll") for (int m = 0; m < 4; ++m)                                                        \
      _Pragma("unroll") for (int n = 0; n < 2; ++n)                                                      \
        _Pragma("unroll") for (int k = 0; k < 2; ++k)                                                    \
          acc[ai][bj][m][n] = __builtin_amdgcn_mfma_f32_16x16x32_bf16(At[m][k], Bt_[n][k], acc[ai][bj][m][n], 0, 0, 0); \
    __builtin_amdgcn_s_setprio(0);                                                                       \
  } while (0)
#define WAIT_V(n) asm volatile("s_waitcnt vmcnt(" #n ")" ::: "memory")
#define WAIT_L(n) asm volatile("s_waitcnt lgkmcnt(" #n ")" ::: "memory")
#define BAR __builtin_amdgcn_s_barrier()
#define SCHED __builtin_amdgcn_sched_barrier(0)
  const int tid = tid_l();
  const int wid = tid >> 6, lane = tid & 63, wr = wid >> 2, wc = wid & 3, fr = lane & 15, fq = lane >> 4;
  bf16x8 At[4][2], B0[2][2], B1[2][2];
  const int nt = K / BK;
  const int lb0 = tid * 16;
  int r_0, c_0, r_1, c_1;
  stage_rc(lb0, r_0, c_0);
  stage_rc(lb0 + 8192, r_1, c_1);
  const int oa0 = r_0 * lda + c_0, oa1 = r_1 * lda + c_1, ob0 = r_0 * ldb + c_0, ob1 = r_1 * ldb + c_1;
  const int brow = 0, bcol = 0;
  STAGE(SB(0, 0), Bt, ldb, bcol, 0);
  STAGE(SA(0, 0), A, lda, brow, 0);
  STAGE(SB(0, 1), Bt, ldb, bcol + HALF, 0);
  STAGE(SA(0, 1), A, lda, brow + HALF, 0);
  if (wr == 1) BAR;
  WAIT_V(4);
  BAR;
  STAGE(SB(1, 0), Bt, ldb, bcol, 1);
  STAGE(SA(1, 0), A, lda, brow, 1);
  STAGE(SB(1, 1), Bt, ldb, bcol + HALF, 1);
  WAIT_V(6);
  BAR;
  for (int t = 0; t < nt - 2; t += 2) {
    LDB(B0, 0, 0); SCHED; LDA(At, 0, 0); STAGE(SA(1, 1), A, lda, brow + HALF, t + 1);
    WAIT_L(8); BAR; WAIT_L(0); MMA(0, 0, At, B0); BAR; SCHED;
    LDB(B1, 0, 1); STAGE(SB(0, 0), Bt, ldb, bcol, t + 2);
    BAR; WAIT_L(0); MMA(0, 1, At, B1); BAR;
    LDA(At, 0, 1); STAGE(SA(0, 0), A, lda, brow, t + 2);
    BAR; WAIT_L(0); MMA(1, 0, At, B0); BAR; SCHED;
    STAGE(SB(0, 1), Bt, ldb, bcol + HALF, t + 2);
    WAIT_V(6); BAR; MMA(1, 1, At, B1); BAR;
    LDB(B0, 1, 0); SCHED; LDA(At, 1, 0); STAGE(SA(0, 1), A, lda, brow + HALF, t + 2);
    WAIT_L(8); BAR; WAIT_L(0); MMA(0, 0, At, B0); BAR; SCHED;
    LDB(B1, 1, 1); STAGE(SB(1, 0), Bt, ldb, bcol, t + 3);
    BAR; WAIT_L(0); MMA(0, 1, At, B1); BAR;
    LDA(At, 1, 1); STAGE(SA(1, 0), A, lda, brow, t + 3);
    BAR; WAIT_L(0); MMA(1, 0, At, B0); BAR; SCHED;
    STAGE(SB(1, 1), Bt, ldb, bcol + HALF, t + 3);
    WAIT_V(6); BAR; MMA(1, 1, At, B1); BAR;
  }
  {
    LDB(B0, 0, 0); LDA(At, 0, 0); STAGE(SA(1, 1), A, lda, brow + HALF, nt - 1);
    BAR; WAIT_L(0); MMA(0, 0, At, B0); BAR;
    LDB(B1, 0, 1); BAR; WAIT_L(0); MMA(0, 1, At, B1); BAR;
    LDA(At, 0, 1); WAIT_V(4); BAR; WAIT_L(0); MMA(1, 0, At, B0); MMA(1, 1, At, B1); BAR;
  }
  {
    LDB(B0, 1, 0); LDA(At, 1, 0); WAIT_V(2); BAR; WAIT_L(0); MMA(0, 0, At, B0); BAR;
    LDB(B1, 1, 1); WAIT_V(0); BAR; WAIT_L(0); MMA(0, 1, At, B1); BAR;
    LDA(At, 1, 1); BAR; WAIT_L(0); MMA(1, 0, At, B0); MMA(1, 1, At, B1); BAR;
  }
  if (wr == 0) BAR;
}

template <class F>
__device__ __forceinline__ void epilogue(f32x4 (&acc)[2][2][4][2], F f) {
  float* tile = (float*)shm;
  int tid = threadIdx.x;
  asm volatile("" : "+v"(tid));
  const int wid = tid >> 6, lane = tid & 63, wr = wid >> 2, wc = wid & 3, fr = lane & 15, fq = lane >> 4;
#pragma unroll
  for (int ai = 0; ai < 2; ++ai) {
    __syncthreads();
#pragma unroll
    for (int bj = 0; bj < 2; ++bj)
#pragma unroll
      for (int m = 0; m < 4; ++m)
#pragma unroll
        for (int n = 0; n < 2; ++n)
#pragma unroll
          for (int j = 0; j < 4; ++j)
            tile[(wr * 64 + m * 16 + fq * 4 + j) * 260 + bj * 128 + wc * 32 + n * 16 + fr] = acc[ai][bj][m][n][j];
    __syncthreads();
#pragma unroll 4
    for (int it = 0; it < 16; ++it) {
      const int idx = it * 512 + tid;
      const int row = idx >> 6, c4 = (idx & 63) * 4;
      const float4 v = *(const float4*)(tile + row * 260 + c4);
      f(ai * 128 + row, c4, v);
    }
  }
  __syncthreads();
}

__device__ __forceinline__ void zero_acc(f32x4 (&acc)[2][2][4][2]) {
#pragma unroll
  for (int a = 0; a < 2; ++a)
#pragma unroll
    for (int b = 0; b < 2; ++b)
#pragma unroll
      for (int m = 0; m < 4; ++m)
#pragma unroll
        for (int n = 0; n < 2; ++n) acc[a][b][m][n] = f32x4{0.f, 0.f, 0.f, 0.f};
}

__device__ void phase_mod(const Params& p) {
  float* sc = (float*)shm;
  float* part = sc + 5 * 1024;
  const int t = tid_l();
  for (int i = t; i < 5 * 1024; i += 512) {
    int v = i >> 10, k = i & 1023;
    float c = v == 0 ? p.in[7][k] : p.in[6][(v - 1) * 1024 + k];
    sc[i] = siluf_(c);
  }
  __syncthreads();
  const int cc = t & 15, kk = t >> 4;
  for (int cgp = blockIdx.x; cgp < 256; cgp += gridDim.x) {
    const int col = cgp * 12 + cc;
    float a[5] = {0.f, 0.f, 0.f, 0.f, 0.f};
    if (cc < 12) {
      const float* w = p.in[9];
      for (int k = kk; k < 1024; k += 32) {
        float wv = w[(size_t)k * 3072 + col];
#pragma unroll
        for (int v = 0; v < 5; ++v) a[v] += sc[v * 1024 + k] * wv;
      }
    }
#pragma unroll
    for (int v = 0; v < 5; ++v) part[(kk * 5 + v) * 16 + cc] = a[v];
    __syncthreads();
    if (t < 80) {
      int v = t >> 4, c2 = t & 15;
      int col2 = cgp * 12 + c2;
      if (c2 < 12) {
        float s = 0.f;
        for (int k2 = 0; k2 < 32; ++k2) s += part[(k2 * 5 + v) * 16 + c2];
        ((float*)(p.ws + WS_MOD))[v * 3072 + col2] = s + p.in[10][col2];
      }
    }
    __syncthreads();
  }
}

__device__ void tr_tile(const float* __restrict__ src, int ld_src, int col0, int nN, bf16* __restrict__ dst, int ld_dst,
                        int kt, int ntile) {
  float* tile = (float*)shm;
  const int t = tid_l();
  const int k0 = kt * 64, n0 = ntile * 64;
  {
    const int n4 = (t & 15) * 4;
    for (int kk = t >> 4; kk < 64; kk += 32) {
      float4 v = make_float4(0.f, 0.f, 0.f, 0.f);
      if (n0 + n4 < nN) v = *reinterpret_cast<const float4*>(src + (size_t)(k0 + kk) * ld_src + col0 + n0 + n4);
      tile[kk * 65 + n4 + 0] = v.x;
      tile[kk * 65 + n4 + 1] = v.y;
      tile[kk * 65 + n4 + 2] = v.z;
      tile[kk * 65 + n4 + 3] = v.w;
    }
  }
  __syncthreads();
  {
    const int n = t >> 3, k8 = (t & 7) * 8;
    if (n0 + n < nN) {
      uint4 o;
      o.x = pack2(tile[(k8 + 0) * 65 + n], tile[(k8 + 1) * 65 + n]);
      o.y = pack2(tile[(k8 + 2) * 65 + n], tile[(k8 + 3) * 65 + n]);
      o.z = pack2(tile[(k8 + 4) * 65 + n], tile[(k8 + 5) * 65 + n]);
      o.w = pack2(tile[(k8 + 6) * 65 + n], tile[(k8 + 7) * 65 + n]);
      *reinterpret_cast<uint4*>(dst + (size_t)(n0 + n) * ld_dst + k0 + k8) = o;
    }
  }
  __syncthreads();
}

__device__ void phase_weights(const Params& p) {
  bf16* WA = (bf16*)(p.ws + WS_WA);
  bf16* WB = (bf16*)(p.ws + WS_WB);
  bf16* WPA = (bf16*)(p.ws + WS_WPA);
  bf16* WPB = (bf16*)(p.ws + WS_WPB);
  bf16* WOUT = (bf16*)(p.ws + WS_WOUT);
  bf16* WL = (bf16*)(p.ws + WS_WL);
  const int total = 768 + 256 + 16 + 256 + 256 + 512 + 256 + 256 + 256 + 128;
  for (int T = blockIdx.x; T < total; T += gridDim.x) {
    int x = T;
    if (x < 768) { tr_tile(p.in[11], 6176, 0, 3072, WA, 1024, x & 15, x >> 4); continue; }
    x -= 768;
    if (x < 256) { tr_tile(p.in[11], 6176, 4096, 1024, WA + (size_t)3072 * 1024, 1024, x & 15, x >> 4); continue; }
    x -= 256;
    if (x < 16) { tr_tile(p.in[11], 6176, 6144, 32, WA + (size_t)4096 * 1024, 1024, x & 15, 0); continue; }
    x -= 16;
    if (x < 256) { tr_tile(p.in[11], 6176, 3072, 1024, WB, 1024, x & 15, x >> 4); continue; }
    x -= 256;
    if (x < 256) { tr_tile(p.in[11], 6176, 5120, 1024, WB + (size_t)1024 * 1024, 1024, x & 15, x >> 4); continue; }
    x -= 256;
    if (x < 512) { tr_tile(p.in[33], 2048, 0, 2048, WB + (size_t)2048 * 1024, 1024, x & 15, x >> 4); continue; }
    x -= 512;
    if (x < 256) { tr_tile(p.in[31], 1024, 0, 1024, WPA, 2048, x & 15, x >> 4); continue; }
    x -= 256;
    if (x < 256) { tr_tile(p.in[32], 1024, 0, 1024, WPB, 2048, x & 15, x >> 4); continue; }
    x -= 256;
    if (x < 256) {
      tr_tile(p.in[35], 1024, 0, 1024, WOUT, 2048, x & 15, x >> 4);
      tr_tile(p.in[35], 1024, 0, 1024, WOUT + 1024, 2048, x & 15, x >> 4);
      continue;
    }
    x -= 256;
    {
      int sub = x >> 2, tt = x & 3;
      int type = sub >> 3, blk = sub & 7;
      const int widx[4] = {21, 23, 26, 28};
      const float* src = p.in[type == 0 ? 21 : type == 1 ? 23 : type == 2 ? 26 : 28] + (size_t)blk * 128 * 128;
      (void)widx;
      tr_tile(src, 128, 0, 128, WL + ((size_t)blk * 512 + type * 128) * 128, 128, tt & 1, tt >> 1);
    }
  }
  {
    uint4 z = make_uint4(0, 0, 0, 0);
    uint4* dst = (uint4*)(WA + (size_t)4128 * 1024);
    const int n16 = 224 * 1024 * 2 / 16;
    for (int i = blockIdx.x * 512 + tid_l(); i < n16; i += gridDim.x * 512) dst[i] = z;
  }
}

__device__ void phase_h(const Params& p, bf16* H) {
  const int t_ = tid_l();
  const int lane = t_ & 63, wv = t_ >> 6;
  const float* nw = p.in[8];
  const float* mod = (const float*)(p.ws + WS_MOD);
  for (int R = blockIdx.x * 8 + wv; R < NTOK; R += gridDim.x * 8) {
    const float4* x4 = (const float4*)xrow(p, R);
    float4 v[4];
    float ss = 0.f;
#pragma unroll
    for (int i = 0; i < 4; ++i) {
      v[i] = x4[lane + 64 * i];
      ss += v[i].x * v[i].x + v[i].y * v[i].y + v[i].z * v[i].z + v[i].w * v[i].w;
    }
    for (int o = 32; o > 0; o >>= 1) ss += __shfl_xor(ss, o);
    const float rstd = rsqrtf(ss * (1.f / 1024.f) + 1e-6f);
    const float* md = mod + modidx(R) * 3072;
#pragma unroll
    for (int i = 0; i < 4; ++i) {
      const int c = (lane + 64 * i) * 4;
      float4 w4 = *(const float4*)(nw + c);
      float4 sh = *(const float4*)(md + c);
      float4 scl = *(const float4*)(md + 1024 + c);
      float h0 = v[i].x * rstd * w4.x * (1.f + scl.x) + sh.x;
      float h1 = v[i].y * rstd * w4.y * (1.f + scl.y) + sh.y;
      float h2 = v[i].z * rstd * w4.z * (1.f + scl.z) + sh.z;
      float h3 = v[i].w * rstd * w4.w * (1.f + scl.w) + sh.w;
      uint2 o;
      o.x = pack2(h0, h1);
      o.y = pack2(h2, h3);
      *(uint2*)(H + (size_t)R * 1024 + c) = o;
    }
  }
}

__device__ __forceinline__ uint2 pack4(float a, float b, float c, float d) {
  uint2 o;
  o.x = pack2(a, b);
  o.y = pack2(c, d);
  return o;
}

__device__ void phase_gemm1a(const Params& p, const bf16* H, int g) {
  const bf16* WA = (const bf16*)(p.ws + WS_WA);
  us* QKV = (us*)(p.ws + WS_QKV);
  us* XB = (us*)(p.ws + WS_XB);
  float* GC = (float*)(p.ws + WS_GC);
  for (int T = blockIdx.x; T < 20 * 17; T += gridDim.x) {
    const int tm = T % 20, tn = T / 20;
    const int r0 = tm * 256, R0 = grow(g, r0);
    f32x4 acc[2][2][4][2];
    zero_acc(acc);
    gemm_tile(H + (size_t)R0 * 1024, 1024, WA + (size_t)tn * 256 * 1024, 1024, 1024, acc);
    if (tn < 12) {
      epilogue(acc, [&](int row, int c4, float4 v) {
        *(uint2*)(QKV + (size_t)(r0 + row) * 3072 + tn * 256 + c4) = pack4(v.x, v.y, v.z, v.w);
      });
    } else if (tn < 16) {
      epilogue(acc, [&](int row, int c4, float4 v) {
        *(uint2*)(XB + (size_t)(r0 + row) * 1024 + (tn - 12) * 256 + c4) = pack4(v.x, v.y, v.z, v.w);
      });
    } else {
      epilogue(acc, [&](int row, int c4, float4 v) {
        if (c4 < 32) *(float4*)(GC + (size_t)(r0 + row) * 32 + c4) = v;
      });
    }
  }
}

__device__ void phase_gemm1b(const Params& p, const bf16* H) {
  const bf16* WB = (const bf16*)(p.ws + WS_WB);
  us* OCAT = (us*)(p.ws + WS_OCAT);
  us* GATE = (us*)(p.ws + WS_GATE);
  const float* bg = p.in[34];
  for (int T = blockIdx.x; T < 80 * 16; T += gridDim.x) {
    const int tm = T % 80, tn = T / 80;
    const int R0 = tm * 256;
    f32x4 acc[2][2][4][2];
    zero_acc(acc);
    gemm_tile(H + (size_t)R0 * 1024, 1024, WB + (size_t)tn * 256 * 1024, 1024, 1024, acc);
    epilogue(acc, [&](int row, int c4, float4 v) {
      if (tn < 8) {
        uint2* ptr = (uint2*)(OCAT + (size_t)(R0 + row) * 2048 + tn * 256 + c4);
        const uint2 o = *ptr;
        *ptr = pack4(__uint_as_float(o.x << 16) * siluf_(v.x), __uint_as_float(o.x & 0xffff0000u) * siluf_(v.y),
                     __uint_as_float(o.y << 16) * siluf_(v.z), __uint_as_float(o.y & 0xffff0000u) * siluf_(v.w));
      } else {
        const int gc = (tn - 8) * 256 + c4;
        const float4 b4 = *(const float4*)(bg + gc);
        *(uint2*)(GATE + (size_t)(R0 + row) * 2048 + gc) =
            pack4(sigmoidf_(v.x + b4.x), sigmoidf_(v.y + b4.y), sigmoidf_(v.z + b4.z), sigmoidf_(v.w + b4.w));
      }
    });
  }
}

__device__ void phase_gemm3(const Params& p) {
  const bf16* OCAT = (const bf16*)(p.ws + WS_OCAT);
  const bf16* WPA = (const bf16*)(p.ws + WS_WPA);
  const bf16* WPB = (const bf16*)(p.ws + WS_WPB);
  us* GATE = (us*)(p.ws + WS_GATE);
  for (int T = blockIdx.x; T < 80 * 8; T += gridDim.x) {
    const int tm = T % 80, tn = T / 80;
    const int R0 = tm * 256;
    f32x4 acc[2][2][4][2];
    zero_acc(acc);
    const bf16* A = OCAT + (size_t)R0 * 2048 + (tn >= 4 ? 1024 : 0);
    const bf16* Bt = tn < 4 ? WPA + (size_t)tn * 256 * 2048 : WPB + (size_t)(tn - 4) * 256 * 2048;
    gemm_tile(A, 2048, Bt, 2048, 1024, acc);
    epilogue(acc, [&](int row, int c4, float4 v) {
      uint2* ptr = (uint2*)(GATE + (size_t)(R0 + row) * 2048 + tn * 256 + c4);
      const uint2 o = *ptr;
      *ptr = pack4(__uint_as_float(o.x << 16) * v.x, __uint_as_float(o.x & 0xffff0000u) * v.y,
                   __uint_as_float(o.y << 16) * v.z, __uint_as_float(o.y & 0xffff0000u) * v.w);
    });
  }
}

__device__ void phase_gemm4(const Params& p) {
  const bf16* TT = (const bf16*)(p.ws + WS_GATE);
  const bf16* WOUT2 = (const bf16*)(p.ws + WS_WOUT);
  const float* mod = (const float*)(p.ws + WS_MOD);
  for (int T = blockIdx.x; T < 80 * 4; T += gridDim.x) {
    const int tm = T % 80, tn = T / 80;
    const int R0 = tm * 256, c0 = tn * 256;
    f32x4 acc[2][2][4][2];
    zero_acc(acc);
    gemm_tile(TT + (size_t)R0 * 2048, 2048, WOUT2 + (size_t)c0 * 2048, 2048, 2048, acc);
    const float* md = mod + modidx(R0) * 3072 + 2048;
    const float* xr = xrow(p, R0);
    epilogue(acc, [&](int row, int c4, float4 v) {
      const int c = c0 + c4;
      const float4 xv = *(const float4*)(xr + (size_t)row * 1024 + c);
      const float4 m4 = *(const float4*)(md + c);
      float4 o;
      o.x = xv.x + m4.x * v.x;
      o.y = xv.y + m4.y * v.y;
      o.z = xv.z + m4.z * v.z;
      o.w = xv.w + m4.w * v.w;
      *(float4*)(p.out + (size_t)(R0 + row) * 1024 + c) = o;
    });
  }
}

__device__ void phase_final(const Params& p) {
  const int t_ = tid_l();
  const int lane = t_ & 63, wv = t_ >> 6;
  const float* fw = p.in[36];
  for (int R = blockIdx.x * 8 + wv; R < NTOK; R += gridDim.x * 8) {
    float4* x4 = (float4*)(p.out + (size_t)R * 1024);
    float4 v[4];
    float ss = 0.f;
#pragma unroll
    for (int i = 0; i < 4; ++i) {
      v[i] = x4[lane + 64 * i];
      ss += v[i].x * v[i].x + v[i].y * v[i].y + v[i].z * v[i].z + v[i].w * v[i].w;
    }
    for (int o = 32; o > 0; o >>= 1) ss += __shfl_xor(ss, o);
    const float rstd = rsqrtf(ss * (1.f / 1024.f) + 1e-6f);
#pragma unroll
    for (int i = 0; i < 4; ++i) {
      float4 w4 = *(const float4*)(fw + (lane + 64 * i) * 4);
      float4 o;
      o.x = v[i].x * rstd * w4.x;
      o.y = v[i].y * rstd * w4.y;
      o.z = v[i].z * rstd * w4.z;
      o.w = v[i].w * rstd * w4.w;
      x4[lane + 64 * i] = o;
    }
  }
}

__device__ __forceinline__ bf16x8 ld8(const us* ptr) { return *reinterpret_cast<const bf16x8*>(ptr); }

__device__ void gdn_prep_item(const Params& p, int item) {
  const int t = tid_l(), lane = t & 63, w = t >> 6;
  const int tc = item >> 3, h = item & 7;
  const int r0 = tc * 64;
  int seq_lo, seq_hi;
  if (tc < 16) { seq_lo = (tc >> 2) * 256; seq_hi = seq_lo + 256; } else { seq_lo = 1024; seq_hi = 5120; }
  const int ci = item;

  char* L = (char*)shm;
  us* qs = (us*)L;
  us* ks = (us*)(L + 17408);
  float* AF = (float*)L;
  float* ABF = (float*)(L + 17408);
  us* kTb = (us*)(L + 34816);
  us* vTb = (us*)(L + 53248);
  float* vec = (float*)(L + 71680);
  float* xbuf = (float*)(L + 73728);
  float* Gv = vec;
  float* Bv = vec + 128;
  float* SCL = vec + 256;

  const us* QKV = (const us*)(p.ws + WS_QKV);
  const float* GC = (const float*)(p.ws + WS_GC);

  if (w == 0) {
    const int i = lane;
    const float* gc = GC + (size_t)(r0 + i) * 32;
    float af = gc[h], bfv = gc[8 + h], ab = gc[16 + h], bb = gc[24 + h];
    float gf = -__expf(p.in[14][h]) * softplusf_(af + p.in[15][h]);
    float gb = -__expf(p.in[16][h]) * softplusf_(ab + p.in[17][h]);
    float betaf = sigmoidf_(bfv), betab = sigmoidf_(bb);
    float s = gf;
    for (int o = 1; o < 64; o <<= 1) {
      float y = __shfl_up(s, o);
      if (lane >= o) s += y;
    }
    float s2 = gb;
    for (int o = 1; o < 64; o <<= 1) {
      float y = __shfl_down(s2, o);
      if (lane + o < 64) s2 += y;
    }
    float glf = __shfl(s, 63), glb = __shfl(s2, 0);
    Gv[i] = s; Gv[64 + i] = s2;
    Bv[i] = betaf; Bv[64 + i] = betab;
    float egf = __expf(s), egb = __expf(s2);
    SCL[i] = betaf; SCL[64 + i] = betaf * egf; SCL[128 + i] = betab; SCL[192 + i] = betab * egb;
    float* EG = (float*)(p.ws + WS_EG);
    float* ES = (float*)(p.ws + WS_ES);
    float* DL = (float*)(p.ws + WS_DL);
    EG[(size_t)(ci * 2 + 0) * 64 + i] = egf;
    EG[(size_t)(ci * 2 + 1) * 64 + i] = egb;
    ES[(size_t)(ci * 2 + 0) * 64 + i] = __expf(glf - s);
    ES[(size_t)(ci * 2 + 1) * 64 + i] = __expf(glb - s2);
    if (i == 0) { DL[ci * 2 + 0] = __expf(glf); DL[ci * 2 + 1] = __expf(glb); }
  }
  {
    const int i = t >> 3, cg8 = t & 7;
    const float* cw = p.in[12];
    const float* cb = p.in[13];
#pragma unroll
    for (int m = 0; m < 3; ++m) {
      const int col = m * 1024 + h * 128 + cg8 * 16;
      float y[16];
#pragma unroll
      for (int c = 0; c < 16; ++c) y[c] = cb[col + c];
#pragma unroll
      for (int tap = 0; tap < 4; ++tap) {
        const int rr = r0 + i - 2 + tap;
        if (rr >= seq_lo && rr < seq_hi) {
          const uint4* src = (const uint4*)(QKV + (size_t)rr * 3072 + col);
          uint4 a = src[0], b = src[1];
          unsigned wds[8] = {a.x, a.y, a.z, a.w, b.x, b.y, b.z, b.w};
          const float* wt = cw + tap * 3072 + col;
#pragma unroll
          for (int c = 0; c < 8; ++c) {
            y[2 * c] += wt[2 * c] * __uint_as_float(wds[c] << 16);
            y[2 * c + 1] += wt[2 * c + 1] * __uint_as_float(wds[c] & 0xffff0000u);
          }
        }
      }
      float ss = 0.f;
#pragma unroll
      for (int c = 0; c < 16; ++c) { y[c] = siluf_(y[c]); ss += y[c] * y[c]; }
      if (m < 2) {
        ss += __shfl_xor(ss, 1);
        ss += __shfl_xor(ss, 2);
        ss += __shfl_xor(ss, 4);
        float inv = rsqrtf(ss + 1e-6f);
        if (m == 0) inv *= 0.08838834764831845f;
#pragma unroll
        for (int c = 0; c < 16; ++c) y[c] *= inv;
      }
      if (m == 0) {
        uint4 o0, o1;
        o0.x = pack2(y[0], y[1]); o0.y = pack2(y[2], y[3]); o0.z = pack2(y[4], y[5]); o0.w = pack2(y[6], y[7]);
        o1.x = pack2(y[8], y[9]); o1.y = pack2(y[10], y[11]); o1.z = pack2(y[12], y[13]); o1.w = pack2(y[14], y[15]);
        *(uint4*)(qs + i * 136 + cg8 * 16) = o0;
        *(uint4*)(qs + i * 136 + cg8 * 16 + 8) = o1;
        us* Qg = (us*)(p.ws + WS_Q) + (size_t)ci * 8192 + i * 128 + cg8 * 16;
        *(uint4*)Qg = o0;
        *(uint4*)(Qg + 8) = o1;
      } else if (m == 1) {
        uint4 o0, o1;
        o0.x = pack2(y[0], y[1]); o0.y = pack2(y[2], y[3]); o0.z = pack2(y[4], y[5]); o0.w = pack2(y[6], y[7]);
        o1.x = pack2(y[8], y[9]); o1.y = pack2(y[10], y[11]); o1.z = pack2(y[12], y[13]); o1.w = pack2(y[14], y[15]);
        *(uint4*)(ks + i * 136 + cg8 * 16) = o0;
        *(uint4*)(ks + i * 136 + cg8 * 16 + 8) = o1;
#pragma unroll
        for (int c = 0; c < 16; ++c) kTb[(cg8 * 16 + c) * 72 + i] = f2bf(y[c]);
      } else {
#pragma unroll
        for (int c = 0; c < 16; ++c) vTb[(cg8 * 16 + c) * 72 + i] = f2bf(y[c]);
      }
    }
  }
  __syncthreads();
  f32x4 acc[4];
  {
    const int mat = w >> 2, mt = w & 3;
    const us* Asrc = mat == 0 ? ks : qs;
#pragma unroll
    for (int n = 0; n < 4; ++n) acc[n] = f32x4{0.f, 0.f, 0.f, 0.f};
#pragma unroll
    for (int kk = 0; kk < 4; ++kk) {
      bf16x8 a = ld8(Asrc + (16 * mt + (lane & 15)) * 136 + kk * 32 + (lane >> 4) * 8);
#pragma unroll
      for (int n = 0; n < 4; ++n) {
        bf16x8 b = ld8(ks + (16 * n + (lane & 15)) * 136 + kk * 32 + (lane >> 4) * 8);
        acc[n] = __builtin_amdgcn_mfma_f32_16x16x32_bf16(a, b, acc[n], 0, 0, 0);
      }
    }
  }
  __syncthreads();
  {
    const int mat = w >> 2, mt = w & 3;
    us* QKM = (us*)(p.ws + WS_QKM);
#pragma unroll
    for (int n = 0; n < 4; ++n)
#pragma unroll
      for (int jj = 0; jj < 4; ++jj) {
        const int i = 16 * mt + 4 * (lane >> 4) + jj, j = 16 * n + (lane & 15);
        const float val = acc[n][jj];
        const float df = __expf(Gv[i] - Gv[j]);
        const float db = __expf(Gv[64 + i] - Gv[64 + j]);
        if (mat == 0) {
          AF[i * 68 + j] = (i > j) ? Bv[i] * val * df : 0.f;
          ABF[(63 - i) * 68 + (63 - j)] = (i < j) ? Bv[64 + i] * val * db : 0.f;
        } else {
          QKM[(size_t)(ci * 2 + 0) * 4096 + i * 64 + j] = f2bf((i >= j) ? val * df : 0.f);
          QKM[(size_t)(ci * 2 + 1) * 4096 + i * 64 + j] = f2bf((i <= j) ? val * db : 0.f);
        }
      }
  }
  {
    us* KT = (us*)(p.ws + WS_KT) + (size_t)ci * 8192;
    for (int idx = t; idx < 8192; idx += 512) KT[idx] = kTb[(idx >> 6) * 72 + (idx & 63)];
  }
  __syncthreads();
#pragma unroll 1
  for (int d = 0; d < 2; ++d) {
    if (t < 256) {
      const int isW = t >> 7, col = t & 127;
      const float* Am = d ? ABF : AF;
      const us* src = (isW ? kTb : vTb) + col * 72;
      const float* scl = SCL + (d * 2 + isW) * 64;
      float* xb = xbuf + t;
      us* dst = (us*)(p.ws + (isW ? WS_WN : WS_U)) + (size_t)(ci * 2 + d) * 8192 + col;
      const float sgn = isW ? -1.f : 1.f;
#pragma unroll 1
      for (int bi = 0; bi < 4; ++bi) {
        float r[16];
#pragma unroll
        for (int ii = 0; ii < 16; ++ii) {
          const int ip = bi * 16 + ii;
          const int i = d ? 63 - ip : ip;
          r[ii] = bf2f(src[i]) * scl[i];
        }
#pragma unroll 1
        for (int bj = 0; bj < bi; ++bj) {
          float xj[16];
#pragma unroll
          for (int jj = 0; jj < 16; ++jj) xj[jj] = xb[(bj * 16 + jj) * 256];
          const float* Ab = Am + (bi * 16) * 68 + bj * 16;
#pragma unroll
          for (int ii = 0; ii < 16; ++ii) {
#pragma unroll
            for (int jj = 0; jj < 16; ++jj) r[ii] -= Ab[ii * 68 + jj] * xj[jj];
          }
        }
        {
          const float* Ab = Am + (bi * 16) * 68 + bi * 16;
#pragma unroll
          for (int ii = 1; ii < 16; ++ii) {
#pragma unroll
            for (int jj = 0; jj < ii; ++jj) r[ii] -= Ab[ii * 68 + jj] * r[jj];
          }
        }
        if (bi < 3) {
#pragma unroll
          for (int ii = 0; ii < 16; ++ii) xb[(bi * 16 + ii) * 256] = r[ii];
        }
#pragma unroll
        for (int ii = 0; ii < 16; ++ii) {
          const int ip = bi * 16 + ii;
          const int i = d ? 63 - ip : ip;
          dst[i * 128] = f2bf(sgn * r[ii]);
        }
      }
    }
    __syncthreads();
  }
}

__device__ void gdn_seq_item(const Params& p, int g, int item, float* OF, float* OB) {
  const int t = tid_l(), lane = t & 63, w = t >> 6;
  int h, d, sl, tc0, nch, seq = -1;
  if (item < 64) { h = item >> 3; d = (item >> 2) & 1; sl = item & 3; tc0 = 16; nch = 64; }
  else { int it = item - 64; seq = it >> 6; int rem = it & 63; h = rem >> 3; d = (rem >> 2) & 1; sl = rem & 3; tc0 = seq * 4; nch = 4; }
  char* L = (char*)shm;
  us* sT = (us*)L;
  us* vT = (us*)(L + 8704);
  us* vsT = (us*)(L + 8704 + 4608);
  const us* Qb = (const us*)(p.ws + WS_Q);
  const us* KTb = (const us*)(p.ws + WS_KT);
  const us* WNb = (const us*)(p.ws + WS_WN);
  const us* Ub = (const us*)(p.ws + WS_U);
  const us* QKMb = (const us*)(p.ws + WS_QKM);
  const float* EG = (const float*)(p.ws + WS_EG);
  const float* ES = (const float*)(p.ws + WS_ES);
  const float* DL = (const float*)(p.ws + WS_DL);
  float* O = d ? OB : OF;
  const int lr = lane & 15, lq = lane >> 4;

  f32x4 s[2];
  if (seq < 0) {
    const float* st = p.in[d ? 3 : 2] + ((size_t)(g * 8 + h) * 128) * 128;
#pragma unroll
    for (int nt = 0; nt < 2; ++nt)
#pragma unroll
      for (int jj = 0; jj < 4; ++jj) s[nt][jj] = st[(size_t)(16 * w + 4 * lq + jj) * 128 + sl * 32 + 16 * nt + lr];
  } else {
    s[0] = f32x4{0.f, 0.f, 0.f, 0.f};
    s[1] = f32x4{0.f, 0.f, 0.f, 0.f};
  }
  __syncthreads();
#pragma unroll
  for (int nt = 0; nt < 2; ++nt) {
    uint2 o;
    o.x = pack2(s[nt][0], s[nt][1]);
    o.y = pack2(s[nt][2], s[nt][3]);
    *(uint2*)(sT + (16 * nt + lr) * 136 + 16 * w + 4 * lq) = o;
  }
  __syncthreads();

  for (int step = 0; step < nch; ++step) {
    const int c = d ? nch - 1 - step : step;
    const int tc = tc0 + c;
    const int ci = tc * 8 + h, cd = ci * 2 + d;
    const int mt = w & 3;
    f32x4 acc[2];
    {
      const us* Ap = (w < 4) ? (WNb + (size_t)cd * 8192) : (Qb + (size_t)ci * 8192);
      bf16x8 a[4];
#pragma unroll
      for (int kk = 0; kk < 4; ++kk) a[kk] = ld8(Ap + (16 * mt + lr) * 128 + kk * 32 + lq * 8);
      if (w < 4) {
        const us* Up = Ub + (size_t)cd * 8192;
#pragma unroll
        for (int nt = 0; nt < 2; ++nt)
#pragma unroll
          for (int jj = 0; jj < 4; ++jj) acc[nt][jj] = bf2f(Up[(16 * mt + 4 * lq + jj) * 128 + sl * 32 + 16 * nt + lr]);
      } else {
        acc[0] = f32x4{0.f, 0.f, 0.f, 0.f};
        acc[1] = f32x4{0.f, 0.f, 0.f, 0.f};
      }
#pragma unroll
      for (int kk = 0; kk < 4; ++kk)
#pragma unroll
        for (int nt = 0; nt < 2; ++nt) {
          bf16x8 b = ld8(sT + (16 * nt + lr) * 136 + kk * 32 + lq * 8);
          acc[nt] = __builtin_amdgcn_mfma_f32_16x16x32_bf16(a[kk], b, acc[nt], 0, 0, 0);
        }
    }
    if (w < 4) {
      float es[4];
#pragma unroll
      for (int jj = 0; jj < 4; ++jj) es[jj] = ES[(size_t)cd * 64 + 16 * mt + 4 * lq + jj];
#pragma unroll
      for (int nt = 0; nt < 2; ++nt) {
        uint2 o, o2;
        o.x = pack2(acc[nt][0], acc[nt][1]);
        o.y = pack2(acc[nt][2], acc[nt][3]);
        o2.x = pack2(acc[nt][0] * es[0], acc[nt][1] * es[1]);
        o2.y = pack2(acc[nt][2] * es[2], acc[nt][3] * es[3]);
        *(uint2*)(vT + (16 * nt + lr) * 72 + 16 * mt + 4 * lq) = o;
        *(uint2*)(vsT + (16 * nt + lr) * 72 + 16 * mt + 4 * lq) = o2;
      }
    }
    __syncthreads();
    if (w >= 4) {
      float eg[4];
#pragma unroll
      for (int jj = 0; jj < 4; ++jj) eg[jj] = EG[(size_t)cd * 64 + 16 * mt + 4 * lq + jj];
#pragma unroll
      for (int nt = 0; nt < 2; ++nt)
#pragma unroll
        for (int jj = 0; jj < 4; ++jj) acc[nt][jj] *= eg[jj];
      const us* Ap = QKMb + (size_t)cd * 4096;
#pragma unroll
      for (int kk = 0; kk < 2; ++kk) {
        bf16x8 a = ld8(Ap + (16 * mt + lr) * 64 + kk * 32 + lq * 8);
#pragma unroll
        for (int nt = 0; nt < 2; ++nt) {
          bf16x8 b = ld8(vT + (16 * nt + lr) * 72 + kk * 32 + lq * 8);
          acc[nt] = __builtin_amdgcn_mfma_f32_16x16x32_bf16(a, b, acc[nt], 0, 0, 0);
        }
      }
      const int rbase = tc * 64 + 16 * mt + 4 * lq;
#pragma unroll
      for (int nt = 0; nt < 2; ++nt)
#pragma unroll
        for (int jj = 0; jj < 4; ++jj) O[(size_t)(rbase + jj) * 1024 + h * 128 + sl * 32 + 16 * nt + lr] = acc[nt][jj];
    }
    {
      const float dl = DL[cd];
#pragma unroll
      for (int nt = 0; nt < 2; ++nt)
#pragma unroll
        for (int jj = 0; jj < 4; ++jj) s[nt][jj] *= dl;
      const us* Ap = KTb + (size_t)ci * 8192;
#pragma unroll
      for (int kk = 0; kk < 2; ++kk) {
        bf16x8 a = ld8(Ap + (16 * w + lr) * 64 + kk * 32 + lq * 8);
#pragma unroll
        for (int nt = 0; nt < 2; ++nt) {
          bf16x8 b = ld8(vsT + (16 * nt + lr) * 72 + kk * 32 + lq * 8);
          s[nt] = __builtin_amdgcn_mfma_f32_16x16x32_bf16(a, b, s[nt], 0, 0, 0);
        }
      }
#pragma unroll
      for (int nt = 0; nt < 2; ++nt) {
        uint2 o;
        o.x = pack2(s[nt][0], s[nt][1]);
        o.y = pack2(s[nt][2], s[nt][3]);
        *(uint2*)(sT + (16 * nt + lr) * 136 + 16 * w + 4 * lq) = o;
      }
    }
    __syncthreads();
  }
  if (seq >= 0) {
    const int b = g * 4 + seq;
    float* dst = p.out + (d ? OUT_SAB : OUT_SAF) + ((size_t)(b * 8 + h) * 128) * 128;
#pragma unroll
    for (int nt = 0; nt < 2; ++nt)
#pragma unroll
      for (int jj = 0; jj < 4; ++jj) dst[(size_t)(16 * w + 4 * lq + jj) * 128 + sl * 32 + 16 * nt + lr] = s[nt][jj];
  }
}

__device__ __forceinline__ int lru_row(int sc, int jj) {
  if (sc < 16) {
    int j = (sc & 3) * 64 + jj;
    if (j < 0 || j >= 256) return -1;
    return (sc >> 2) * 256 + j;
  } else {
    int j = (sc - 16) * 64 + jj;
    if (j < 0 || j >= 4096) return -1;
    return 1024 + (j & 63) * 64 + (j >> 6);
  }
}

__device__ void lru_item(const Params& p, int g, int item, int pass) {
  const int t = tid_l(), lane = t & 63, w = t >> 6;
  const int sc = item >> 3, blk = item & 7;
  const int lr = lane & 15, lq = lane >> 4;
  char* L = (char*)shm;
  float* xcf = (float*)L;
  float* Aa = (float*)(L + 32768);
  float* Bb = (float*)(L + 65536);
  float* HF = (float*)(L + 98304);
  us* xcb = (us*)(L + 98304);
  float* carry = (float*)(L + 131072);
  float* stage = (float*)(L + 32768);
  const us* XB = (const us*)(p.ws + WS_XB);
  float* AGG = (float*)(p.ws + WS_AGG);
  const int cidx = sc < 16 ? (sc & 3) : sc - 16;
  const int nch = sc < 16 ? 4 : 64;
  const int sc0 = sc < 16 ? (sc & ~3) : 16;

  __syncthreads();
  if (pass == 1) {
    const int nf = cidx, nb = nch - 1 - cidx;
    for (int idx = t; idx < (nf + nb) * 256; idx += 512) {
      int e = idx >> 8, rem = idx & 255, ab = rem >> 7, ch = rem & 127;
      int cp, dir;
      if (e < nf) { cp = e; dir = 0; } else { cp = nch - 1 - (e - nf); dir = 1; }
      stage[idx] = AGG[((size_t)((sc0 + cp) * 2 + dir) * 2 + ab) * 1024 + blk * 128 + ch];
    }
    __syncthreads();
    if (t < 256) {
      const int dir = t >> 7, ch = t & 127;
      float hh = 0.f;
      if (sc >= 16) hh = p.in[dir ? 5 : 4][(size_t)g * 1024 + blk * 128 + ch];
      const int e0 = dir ? nf : 0, ne = dir ? nb : nf;
      for (int e = 0; e < ne; ++e) hh = stage[(e0 + e) * 256 + ch] * hh + stage[(e0 + e) * 256 + 128 + ch];
      carry[dir * 128 + ch] = hh;
    }
    __syncthreads();
  }
  {
    const int pp = t >> 3, cg8 = t & 7;
    const int chg = blk * 128 + cg8 * 16;
    const float* cw = p.in[19];
    const float* cb = p.in[20];
    float y[16];
#pragma unroll
    for (int c = 0; c < 16; ++c) y[c] = cb[chg + c];
#pragma unroll
    for (int tap = 0; tap < 4; ++tap) {
      const int row = lru_row(sc, pp - 2 + tap);
      if (row >= 0) {
        const uint4* src = (const uint4*)(XB + (size_t)row * 1024 + chg);
        uint4 a = src[0], b = src[1];
        unsigned wds[8] = {a.x, a.y, a.z, a.w, b.x, b.y, b.z, b.w};
        const float* wt = cw + tap * 1024 + chg;
#pragma unroll
        for (int c = 0; c < 8; ++c) {
          y[2 * c] += wt[2 * c] * __uint_as_float(wds[c] << 16);
          y[2 * c + 1] += wt[2 * c + 1] * __uint_as_float(wds[c] & 0xffff0000u);
        }
      }
    }
#pragma unroll
    for (int c = 0; c < 16; ++c) xcf[pp * 128 + cg8 * 16 + c] = y[c];
    uint4 o0, o1;
    o0.x = pack2(y[0], y[1]); o0.y = pack2(y[2], y[3]); o0.z = pack2(y[4], y[5]); o0.w = pack2(y[6], y[7]);
    o1.x = pack2(y[8], y[9]); o1.y = pack2(y[10], y[11]); o1.z = pack2(y[12], y[13]); o1.w = pack2(y[14], y[15]);
    *(uint4*)(xcb + pp * 136 + cg8 * 16) = o0;
    *(uint4*)(xcb + pp * 136 + cg8 * 16 + 8) = o1;
  }
  __syncthreads();
  f32x4 acc[4][4];
  {
    const us* WL = (const us*)(p.ws + WS_WL) + (size_t)blk * 512 * 128;
#pragma unroll
    for (int ty = 0; ty < 4; ++ty)
#pragma unroll
      for (int m = 0; m < 4; ++m) acc[ty][m] = f32x4{0.f, 0.f, 0.f, 0.f};
#pragma unroll
    for (int kk = 0; kk < 4; ++kk) {
      bf16x8 a[4], b[4];
#pragma unroll
      for (int m = 0; m < 4; ++m) a[m] = ld8(xcb + (16 * m + lr) * 136 + kk * 32 + lq * 8);
#pragma unroll
      for (int ty = 0; ty < 4; ++ty) b[ty] = ld8(WL + (size_t)(ty * 128 + 16 * w + lr) * 128 + kk * 32 + lq * 8);
#pragma unroll
      for (int ty = 0; ty < 4; ++ty)
#pragma unroll
        for (int m = 0; m < 4; ++m) acc[ty][m] = __builtin_amdgcn_mfma_f32_16x16x32_bf16(a[m], b[ty], acc[ty][m], 0, 0, 0);
    }
  }
  __syncthreads();
  const int chl = 16 * w + lr, chg1 = blk * 128 + chl;
#pragma unroll
  for (int dir = 0; dir < 2; ++dir) {
    {
      const float ba = p.in[dir ? 27 : 22][chg1], bx = p.in[dir ? 29 : 24][chg1];
      const float spl = softplusf_(-p.in[dir ? 30 : 25][chg1]);
#pragma unroll
      for (int m = 0; m < 4; ++m)
#pragma unroll
        for (int jj = 0; jj < 4; ++jj) {
          const int pos = 16 * m + 4 * lq + jj;
          float r = sigmoidf_(acc[dir * 2][m][jj] + ba);
          float ig = sigmoidf_(acc[dir * 2 + 1][m][jj] + bx);
          float la = -8.f * r * spl;
          float a = __expf(la);
          float bb = sqrtf(-expm1f(2.f * la)) * ig * xcf[pos * 128 + chl];
          Aa[pos * 128 + chl] = a;
          Bb[pos * 128 + chl] = bb;
        }
    }
    __syncthreads();
    if (t < 128) {
      const int ch = t, chg = blk * 128 + ch;
      if (pass == 0) {
        float ap = 1.f, hh = 0.f;
        if (dir == 0) {
          _Pragma("unroll 8") for (int pp = 0; pp < 64; ++pp) { float a = Aa[pp * 128 + ch]; hh = a * hh + Bb[pp * 128 + ch]; ap *= a; }
        } else {
          _Pragma("unroll 8") for (int pp = 63; pp >= 0; --pp) { float a = Aa[pp * 128 + ch]; hh = a * hh + Bb[pp * 128 + ch]; ap *= a; }
        }
        AGG[((size_t)(sc * 2 + dir) * 2 + 0) * 1024 + chg] = ap;
        AGG[((size_t)(sc * 2 + dir) * 2 + 1) * 1024 + chg] = hh;
      } else {
        float hh = carry[dir * 128 + ch];
        if (dir == 0) {
          _Pragma("unroll 8") for (int pp = 0; pp < 64; ++pp) { hh = Aa[pp * 128 + ch] * hh + Bb[pp * 128 + ch]; HF[pp * 128 + ch] = hh; }
          if (sc < 16 && cidx == 3) p.out[OUT_SBF + (size_t)(g * 4 + (sc >> 2)) * 1024 + chg] = hh;
        } else {
          _Pragma("unroll 8") for (int pp = 63; pp >= 0; --pp) { hh = Aa[pp * 128 + ch] * hh + Bb[pp * 128 + ch]; HF[pp * 128 + ch] += hh; }
          if (sc < 16 && cidx == 0) p.out[OUT_SBB + (size_t)(g * 4 + (sc >> 2)) * 1024 + chg] = hh;
        }
      }
    }
    __syncthreads();
  }
  if (pass == 1) {
    us* OCAT = (us*)(p.ws + WS_OCAT);
    const int pp = t >> 3, cg8 = t & 7;
    const int R = grow(g, lru_row(sc, pp));
    const float* hs = HF + pp * 128 + cg8 * 16;
    uint4 o0, o1;
    o0.x = pack2(hs[0], hs[1]); o0.y = pack2(hs[2], hs[3]); o0.z = pack2(hs[4], hs[5]); o0.w = pack2(hs[6], hs[7]);
    o1.x = pack2(hs[8], hs[9]); o1.y = pack2(hs[10], hs[11]); o1.z = pack2(hs[12], hs[13]); o1.w = pack2(hs[14], hs[15]);
    us* dst = OCAT + (size_t)R * 2048 + 1024 + blk * 128 + cg8 * 16;
    *(uint4*)dst = o0;
    *(uint4*)(dst + 8) = o1;
  }
  __syncthreads();
}

__device__ void phase_finalize(const Params& p, int g, const float* OF, const float* OB) {
  const int t_ = tid_l();
  const int lane = t_ & 63, wv = t_ >> 6;
  const float* ow = p.in[18];
  us* OCAT = (us*)(p.ws + WS_OCAT);
  for (int r = blockIdx.x * 8 + wv; r < GR; r += gridDim.x * 8) {
    const int R = grow(g, r);
    const int e0 = lane * 16;
    float o[16];
    float ss = 0.f;
#pragma unroll
    for (int i = 0; i < 4; ++i) {
      float4 a = *(const float4*)(OF + (size_t)r * 1024 + e0 + 4 * i);
      float4 b = *(const float4*)(OB + (size_t)r * 1024 + e0 + 4 * i);
      o[4 * i] = a.x + b.x; o[4 * i + 1] = a.y + b.y; o[4 * i + 2] = a.z + b.z; o[4 * i + 3] = a.w + b.w;
    }
#pragma unroll
    for (int i = 0; i < 16; ++i) ss += o[i] * o[i];
    ss += __shfl_xor(ss, 1);
    ss += __shfl_xor(ss, 2);
    ss += __shfl_xor(ss, 4);
    const float rstd = rsqrtf(ss * (1.f / 128.f) + 1e-6f);
    const int wo = (lane & 7) * 16;
    uint4 o0, o1;
    float y[16];
#pragma unroll
    for (int i = 0; i < 16; ++i) y[i] = o[i] * rstd * ow[wo + i];
    o0.x = pack2(y[0], y[1]); o0.y = pack2(y[2], y[3]); o0.z = pack2(y[4], y[5]); o0.w = pack2(y[6], y[7]);
    o1.x = pack2(y[8], y[9]); o1.y = pack2(y[10], y[11]); o1.z = pack2(y[12], y[13]); o1.w = pack2(y[14], y[15]);
    us* dst = OCAT + (size_t)R * 2048 + e0;
    *(uint4*)dst = o0;
    *(uint4*)(dst + 8) = o1;
  }
}

__global__ void __launch_bounds__(512) fwd_megakernel(Params p) {
  cg::grid_group grid = cg::this_grid();
  bf16* H = (bf16*)p.out;
  float* OF = p.out + (size_t)NTOK * 512;
  float* OB = OF + (size_t)GR * 1024;

  phase_mod(p);
  phase_weights(p);
  grid.sync();
  phase_h(p, H);
  grid.sync();
  for (int g = 0; g < NG; ++g) {
    phase_gemm1a(p, H, g);
    if (g > 0) phase_finalize(p, g - 1, OF, OB);
    grid.sync();
    for (int it = blockIdx.x; it < 1280; it += gridDim.x) {
      if (it < 640) gdn_prep_item(p, it);
      else lru_item(p, g, it - 640, 0);
    }
    grid.sync();
    {
      const int b = blockIdx.x, G = gridDim.x;
      if (G >= 128) {
        if (b < 64) gdn_seq_item(p, g, b, OF, OB);
        else {
          const int nb = G - 64;
          for (int it = 64 + (b - 64); it < 320; it += nb) gdn_seq_item(p, g, it, OF, OB);
          for (int it = b - 64; it < 640; it += nb) lru_item(p, g, it, 1);
        }
      } else {
        for (int it = b; it < 320; it += G) gdn_seq_item(p, g, it, OF, OB);
        for (int it = b; it < 640; it += G) lru_item(p, g, it, 1);
      }
    }
    grid.sync();
  }
  phase_finalize(p, NG - 1, OF, OB);
  grid.sync();
  phase_gemm1b(p, H);
  grid.sync();
  phase_gemm3(p);
  grid.sync();
  phase_gemm4(p);
  grid.sync();
  phase_final(p);
}

extern "C" void kernel_launch(void* const* d_in, const int* in_sizes, int n_in, void* d_out, int out_size, void* d_ws,
                              size_t ws_size, hipStream_t stream) {
  static int grid_blocks = 0;
  if (grid_blocks == 0) {
    int dev = 0, cus = 0, per_cu = 0;
    hipGetDevice(&dev);
    hipDeviceGetAttribute(&cus, hipDeviceAttributeMultiprocessorCount, dev);
    if (hipFuncSetAttribute((const void*)fwd_megakernel, hipFuncAttributeMaxDynamicSharedMemorySize, LDS_BYTES) != hipSuccess)
      fprintf(stderr, "hipFuncSetAttribute failed\n");
    hipOccupancyMaxActiveBlocksPerMultiprocessor(&per_cu, (const void*)fwd_megakernel, 512, LDS_BYTES);
    if (per_cu < 1) { fprintf(stderr, "occupancy query says %d blocks/CU\n", per_cu); per_cu = 1; }
    if (per_cu > 1) per_cu = 1;
    grid_blocks = cus * per_cu;
    if (ws_size < WS_END) fprintf(stderr, "workspace too small: %zu < %zu\n", ws_size, (size_t)WS_END);
  }
  Params p{};
  for (int i = 0; i < 37; ++i) p.in[i] = (const float*)d_in[i];
  p.out = (float*)d_out;
  p.ws = (char*)d_ws;
  void* args[] = {&p};
  hipError_t e = hipLaunchCooperativeKernel((const void*)fwd_megakernel, dim3(grid_blocks), dim3(512), args, LDS_BYTES, stream);
  if (e != hipSuccess) fprintf(stderr, "cooperative launch failed: %s (grid %d)\n", hipGetErrorString(e), grid_blocks);
}
```

```cpp
#include <hip/hip_runtime.h>
#include <hip/hip_bf16.h>
#include <hip/hip_cooperative_groups.h>
#include <cstdio>
#include <cstdint>
#include <type_traits>
namespace cg = cooperative_groups;

using bf16 = __hip_bfloat16;
using bf16x8 = __attribute__((ext_vector_type(8))) short;
using f32x4 = __attribute__((ext_vector_type(4))) float;
typedef unsigned short us;

constexpr int DM = 1024;
constexpr int NTOK = 20480;
constexpr int NG = 4;
constexpr int GR = 5120;
constexpr int NA = 4352;
constexpr int NB1 = 4096;
constexpr int OUT_SAF = 20971520, OUT_SAB = 23068672, OUT_SBF = 25165824, OUT_SBB = 25182208;

constexpr size_t WS_WA = 0;
constexpr size_t WS_WB = WS_WA + (size_t)NA * 1024 * 2;
constexpr size_t WS_WPA = WS_WB + (size_t)NB1 * 1024 * 2;
constexpr size_t WS_WPB = WS_WPA + 4194304;
constexpr size_t WS_WOUT = WS_WPB + 4194304;
constexpr size_t WS_WL = WS_WOUT + 4194304;
constexpr size_t WS_MOD = WS_WL + 1048576;
constexpr size_t WS_OCAT = WS_MOD + 65536;
constexpr size_t WS_BIG = WS_OCAT + (size_t)NTOK * 2048 * 2;
constexpr size_t WS_QKV = WS_BIG;
constexpr size_t WS_XB = WS_QKV + (size_t)GR * 3072 * 2;
constexpr size_t WS_GC = WS_XB + (size_t)GR * 1024 * 2;
constexpr size_t WS_AGG = WS_GC + (size_t)GR * 32 * 4;
constexpr size_t WS_Q = WS_AGG + (size_t)80 * 4 * 1024 * 4;
constexpr size_t WS_KT = WS_Q + (size_t)640 * 8192 * 2;
constexpr size_t WS_WN = WS_KT + (size_t)640 * 8192 * 2;
constexpr size_t WS_U = WS_WN + (size_t)1280 * 8192 * 2;
constexpr size_t WS_QKM = WS_U + (size_t)1280 * 8192 * 2;
constexpr size_t WS_EG = WS_QKM + (size_t)1280 * 4096 * 2;
constexpr size_t WS_ES = WS_EG + (size_t)1280 * 64 * 4;
constexpr size_t WS_DL = WS_ES + (size_t)1280 * 64 * 4;
constexpr size_t WS_GEND = WS_DL + 8192;
constexpr size_t WS_GATE = WS_BIG;
constexpr size_t WS_END = WS_GATE + (size_t)NTOK * 2048 * 2;
static_assert(WS_GEND <= 268435456ull, "group region too large");
constexpr size_t WS_OF = (WS_END > WS_GEND ? WS_END : WS_GEND);
constexpr size_t WS_OB = WS_OF + (size_t)GR * 1024 * 2;
constexpr size_t WS_XB2 = WS_OB + (size_t)GR * 1024 * 2;
constexpr size_t WS_BAR = WS_XB2 + (size_t)GR * 1024 * 2;
constexpr size_t WS_END2 = WS_BAR + 16384;
static_assert(WS_END2 <= 268435456ull, "workspace too large");

#ifndef PROBE_MASK
#define PROBE_MASK 0
#endif
constexpr int LDS_BYTES = 147456;

struct Params {
  const float* in[37];
  float* out;
  char* ws;
};

extern __shared__ __attribute__((aligned(16))) bf16 shm[];

typedef __bf16 hwbf2 __attribute__((ext_vector_type(2)));
typedef float hwf2 __attribute__((ext_vector_type(2)));
__device__ __forceinline__ us f2bf(float f) { return __builtin_bit_cast(us, (__bf16)f); }
__device__ __forceinline__ float bf2f(us b) { return __uint_as_float(((unsigned)b) << 16); }
__device__ __forceinline__ float frcp_(float x) { return __builtin_amdgcn_rcpf(x); }
__device__ __forceinline__ float sigmoidf_(float x) { return frcp_(1.f + __expf(-x)); }
__device__ __forceinline__ float siluf_(float x) { return x * frcp_(1.f + __expf(-x)); }
__device__ __forceinline__ float softplusf_(float x) { return x > 20.f ? x : log1pf(__expf(x)); }
__device__ __forceinline__ unsigned pack2(float a, float b) {
  hwf2 v = {a, b};
  return __builtin_bit_cast(unsigned, __builtin_convertvector(v, hwbf2));
}

__device__ __forceinline__ void lds_barrier() {
  asm volatile("s_waitcnt lgkmcnt(0)" ::: "memory");
  __builtin_amdgcn_s_barrier();
  asm volatile("" ::: "memory");
}

__device__ __forceinline__ int zopaque() {
  int z;
  asm volatile("s_mov_b32 %0, 0" : "=s"(z));
  return z;
}
#define IN(K) (p.in[(K) + zopaque()])

__device__ __forceinline__ int tid_l() {
  int t = threadIdx.x;
  asm volatile("" : "+v"(t));
  return t;
}

__device__ __forceinline__ float shfl_lane(float v, int src_lane) {
  return __int_as_float(__builtin_amdgcn_ds_bpermute(src_lane << 2, __float_as_int(v)));
}

__device__ __forceinline__ int grow(int g, int r) {
  return r < 1024 ? g * 1024 + r : 4096 + g * 4096 + (r - 1024);
}
__device__ __forceinline__ const float* xrow(const Params& p, int R) {
  return R < 4096 ? IN(0) + (size_t)R * 1024 : IN(1) + (size_t)(R - 4096) * 1024;
}
__device__ __forceinline__ int modidx(int R) { return R < 4096 ? 0 : 1 + ((R - 4096) >> 12); }

constexpr int BK = 64, HALF = 128, HT = HALF * BK;
__device__ __forceinline__ int lds_byte(int r, int c) {
  int st = (r >> 4) * 2 + (c >> 5), rr = r & 15, cc = c & 31, ob = rr * 64 + cc * 2;
  return st * 1024 + (ob ^ (((ob >> 9) & 1) << 5));
}
__device__ __forceinline__ void stage_rc(int b, int& R, int& C) {
  int st = b / 1024, sb = b % 1024, swz = sb ^ (((sb >> 9) & 1) << 5);
  R = (st >> 1) * 16 + swz / 64;
  C = (st & 1) * 32 + (swz % 64) / 2;
}

__device__ __forceinline__ void gemm_tile(const bf16* __restrict__ A, int lda, const bf16* __restrict__ Bt, int ldb, int K,
                                          f32x4 (&acc)[2][2][4][2]) {
#define SA(b, h) (shm + ((b)*2 + (h)) * HT)
#define SB(b, h) (shm + (4 + (b)*2 + (h)) * HT)
#define STAGE(P, BASE, LD, br, kt)                                                                       \
  do {                                                                                                   \
    const bf16* _gb = (BASE) + ((long)(br) * (LD) + (long)(kt)*BK);                                      \
    const int _o0 = ((LD) == lda) ? oa0 : ob0, _o1 = ((LD) == lda) ? oa1 : ob1;                          \
    __builtin_amdgcn_global_load_lds((const unsigned*)(_gb + _o0), (unsigned*)((char*)(P) + lb0), 16, 0, 0); \
    __builtin_amdgcn_global_load_lds((const unsigned*)(_gb + _o1), (unsigned*)((char*)(P) + lb0 + 8192), 16, 0, 0); \
  } while (0)
#define LDA(dst, b, h)                                                                                   \
  _Pragma("unroll") for (int m = 0; m < 4; ++m)                                                          \
    _Pragma("unroll") for (int k = 0; k < 2; ++k)                                                        \
  dst[m][k] = *reinterpret_cast<const bf16x8*>((char*)shm + (((b)*2 + (h)) * 16384 + m * 2048 + k * 1024) + baseA)
#define LDB(dst, b, h)                                                                                   \
  _Pragma("unroll") for (int n = 0; n < 2; ++n)                                                          \
    _Pragma("unroll") for (int k = 0; k < 2; ++k)                                                        \
  dst[n][k] = *reinterpret_cast<const bf16x8*>((char*)shm + ((4 + (b)*2 + (h)) * 16384 + n * 2048 + k * 1024) + baseB)
#define MMA(ai, bj, At, Bt_)                                                                             \
  do {                                                                                                   \
    __builtin_amdgcn_s_setprio(1);                                                                       \
    _Pragma("unroll") for (int m = 0; m < 4; ++m)                                                        \
      _Pragma("unroll") for (int n = 0; n < 2; ++n)                                                      \
        _Pragma("unroll") for (int k = 0; k < 2; ++k)                                                    \
          acc[ai][bj][m][n] = __builtin_amdgcn_mfma_f32_16x16x32_bf16(At[m][k], Bt_[n][k], acc[ai][bj][m][n], 0, 0, 0); \
    __builtin_amdgcn_s_setprio(0);                                                                       \
  } while (0)
#define WAIT_V(n) asm volatile("s_waitcnt vmcnt(" #n ")" ::: "memory")
#define WAIT_L(n) asm volatile("s_waitcnt lgkmcnt(" #n ")" ::: "memory")
#define BAR __builtin_amdgcn_s_barrier()
#define SCHED __builtin_amdgcn_sched_barrier(0)
  const int tid = tid_l();
  const int wid = tid >> 6, lane = tid & 63, wr = wid >> 2, wc = wid & 3, fr = lane & 15, fq = lane >> 4;
  bf16x8 At[4][2], B0[2][2], B1[2][2];
  const int nt = K / BK;
  const int ob_ = fr * 64 + fq * 16;
  const int swz_ = ob_ ^ (((ob_ >> 9) & 1) << 5);
  const int baseA = wr * 8192 + swz_, baseB = wc * 4096 + swz_;
  const int lb0 = tid * 16;
  int r_0, c_0, r_1, c_1;
  stage_rc(lb0, r_0, c_0);
  stage_rc(lb0 + 8192, r_1, c_1);
  const int oa0 = r_0 * lda + c_0, oa1 = r_1 * lda + c_1, ob0 = r_0 * ldb + c_0, ob1 = r_1 * ldb + c_1;
  const int brow = 0, bcol = 0;
  STAGE(SB(0, 0), Bt, ldb, bcol, 0);
  STAGE(SA(0, 0), A, lda, brow, 0);
  STAGE(SB(0, 1), Bt, ldb, bcol + HALF, 0);
  STAGE(SA(0, 1), A, lda, brow + HALF, 0);
  if (wr == 1) BAR;
  WAIT_V(4);
  BAR;
  STAGE(SB(1, 0), Bt, ldb, bcol, 1);
  STAGE(SA(1, 0), A, lda, brow, 1);
  STAGE(SB(1, 1), Bt, ldb, bcol + HALF, 1);
  WAIT_V(6);
  BAR;
  for (int t = 0; t < nt - 2; t += 2) {
    LDB(B0, 0, 0); SCHED; LDA(At, 0, 0); STAGE(SA(1, 1), A, lda, brow + HALF, t + 1);
    WAIT_L(8); BAR; WAIT_L(0); MMA(0, 0, At, B0); BAR; SCHED;
    LDB(B1, 0, 1); STAGE(SB(0, 0), Bt, ldb, bcol, t + 2);
    BAR; WAIT_L(0); MMA(0, 1, At, B1); BAR;
    LDA(At, 0, 1); STAGE(SA(0, 0), A, lda, brow, t + 2);
    BAR; WAIT_L(0); MMA(1, 0, At, B0); BAR; SCHED;
    STAGE(SB(0, 1), Bt, ldb, bcol + HALF, t + 2);
    WAIT_V(6); BAR; MMA(1, 1, At, B1); BAR;
    LDB(B0, 1, 0); SCHED; LDA(At, 1, 0); STAGE(SA(0, 1), A, lda, brow + HALF, t + 2);
    WAIT_L(8); BAR; WAIT_L(0); MMA(0, 0, At, B0); BAR; SCHED;
    LDB(B1, 1, 1); STAGE(SB(1, 0), Bt, ldb, bcol, t + 3);
    BAR; WAIT_L(0); MMA(0, 1, At, B1); BAR;
    LDA(At, 1, 1); STAGE(SA(1, 0), A, lda, brow, t + 3);
    BAR; WAIT_L(0); MMA(1, 0, At, B0); BAR; SCHED;
    STAGE(SB(1, 1), Bt, ldb, bcol + HALF, t + 3);
    WAIT_V(6); BAR; MMA(1, 1, At, B1); BAR;
  }
  {
    LDB(B0, 0, 0); LDA(At, 0, 0); STAGE(SA(1, 1), A, lda, brow + HALF, nt - 1);
    BAR; WAIT_L(0); MMA(0, 0, At, B0); BAR;
    LDB(B1, 0, 1); BAR; WAIT_L(0); MMA(0, 1, At, B1); BAR;
    LDA(At, 0, 1); WAIT_V(4); BAR; WAIT_L(0); MMA(1, 0, At, B0); MMA(1, 1, At, B1); BAR;
  }
  {
    LDB(B0, 1, 0); LDA(At, 1, 0); WAIT_V(2); BAR; WAIT_L(0); MMA(0, 0, At, B0); BAR;
    LDB(B1, 1, 1); WAIT_V(0); BAR; WAIT_L(0); MMA(0, 1, At, B1); BAR;
    LDA(At, 1, 1); BAR; WAIT_L(0); MMA(1, 0, At, B0); MMA(1, 1, At, B1); BAR;
  }
  if (wr == 0) BAR;
}

template <class F>
__device__ __forceinline__ void epilogue(f32x4 (&acc)[2][2][4][2], F f) {
  float* tile = (float*)shm;
  int tid = threadIdx.x;
  asm volatile("" : "+v"(tid));
  const int wid = tid >> 6, lane = tid & 63, wr = wid >> 2, wc = wid & 3, fr = lane & 15, fq = lane >> 4;
#pragma unroll
  for (int ai = 0; ai < 2; ++ai) {
    lds_barrier();
#pragma unroll
    for (int bj = 0; bj < 2; ++bj)
#pragma unroll
      for (int m = 0; m < 4; ++m)
#pragma unroll
        for (int n = 0; n < 2; ++n)
#pragma unroll
          for (int j = 0; j < 4; ++j)
            tile[(wr * 64 + m * 16 + fq * 4 + j) * 260 + bj * 128 + wc * 32 + n * 16 + fr] = acc[ai][bj][m][n][j];
    lds_barrier();
#pragma unroll 4
    for (int it = 0; it < 16; ++it) {
      const int idx = it * 512 + tid;
      const int row = idx >> 6, c4 = (idx & 63) * 4;
      const float4 v = *(const float4*)(tile + row * 260 + c4);
      f(ai * 128 + row, c4, v);
    }
  }
  lds_barrier();
}

__device__ __forceinline__ void zero_acc(f32x4 (&acc)[2][2][4][2]) {
#pragma unroll
  for (int a = 0; a < 2; ++a)
#pragma unroll
    for (int b = 0; b < 2; ++b)
#pragma unroll
      for (int m = 0; m < 4; ++m)
#pragma unroll
        for (int n = 0; n < 2; ++n) acc[a][b][m][n] = f32x4{0.f, 0.f, 0.f, 0.f};
}

__device__ void phase_mod(const Params& p) {
  float* sc = (float*)shm;
  float* part = sc + 5 * 1024;
  const int t = tid_l();
  for (int i = t; i < 5 * 1024; i += 512) {
    int v = i >> 10, k = i & 1023;
    float c = v == 0 ? IN(7)[k] : IN(6)[(v - 1) * 1024 + k];
    sc[i] = siluf_(c);
  }
  lds_barrier();
  const int cc = t & 15, kk = t >> 4;
  for (int cgp = blockIdx.x; cgp < 256; cgp += gridDim.x) {
    const int col = cgp * 12 + cc;
    float a[5] = {0.f, 0.f, 0.f, 0.f, 0.f};
    if (cc < 12) {
      const float* w = IN(9);
      for (int k = kk; k < 1024; k += 32) {
        float wv = w[(size_t)k * 3072 + col];
#pragma unroll
        for (int v = 0; v < 5; ++v) a[v] += sc[v * 1024 + k] * wv;
      }
    }
#pragma unroll
    for (int v = 0; v < 5; ++v) part[(kk * 5 + v) * 16 + cc] = a[v];
    lds_barrier();
    if (t < 80) {
      int v = t >> 4, c2 = t & 15;
      int col2 = cgp * 12 + c2;
      if (c2 < 12) {
        float s = 0.f;
        for (int k2 = 0; k2 < 32; ++k2) s += part[(k2 * 5 + v) * 16 + c2];
        ((float*)(p.ws + WS_MOD))[v * 3072 + col2] = s + IN(10)[col2];
      }
    }
    lds_barrier();
  }
}

__device__ void tr_tile(const float* __restrict__ src, int ld_src, int col0, int nN, bf16* __restrict__ dst, int ld_dst,
                        int kt, int ntile) {
  float* tile = (float*)shm;
  const int t = tid_l();
  const int k0 = kt * 64, n0 = ntile * 64;
  {
    const int n4 = (t & 15) * 4;
    for (int kk = t >> 4; kk < 64; kk += 32) {
      float4 v = make_float4(0.f, 0.f, 0.f, 0.f);
      if (n0 + n4 < nN) v = *reinterpret_cast<const float4*>(src + (size_t)(k0 + kk) * ld_src + col0 + n0 + n4);
      tile[kk * 65 + n4 + 0] = v.x;
      tile[kk * 65 + n4 + 1] = v.y;
      tile[kk * 65 + n4 + 2] = v.z;
      tile[kk * 65 + n4 + 3] = v.w;
    }
  }
  lds_barrier();
  {
    const int n = t >> 3, k8 = (t & 7) * 8;
    if (n0 + n < nN) {
      uint4 o;
      o.x = pack2(tile[(k8 + 0) * 65 + n], tile[(k8 + 1) * 65 + n]);
      o.y = pack2(tile[(k8 + 2) * 65 + n], tile[(k8 + 3) * 65 + n]);
      o.z = pack2(tile[(k8 + 4) * 65 + n], tile[(k8 + 5) * 65 + n]);
      o.w = pack2(tile[(k8 + 6) * 65 + n], tile[(k8 + 7) * 65 + n]);
      *reinterpret_cast<uint4*>(dst + (size_t)(n0 + n) * ld_dst + k0 + k8) = o;
    }
  }
  lds_barrier();
}

__device__ void phase_weights(const Params& p) {
  bf16* WA = (bf16*)(p.ws + WS_WA);
  bf16* WB = (bf16*)(p.ws + WS_WB);
  bf16* WPA = (bf16*)(p.ws + WS_WPA);
  bf16* WPB = (bf16*)(p.ws + WS_WPB);
  bf16* WOUT = (bf16*)(p.ws + WS_WOUT);
  bf16* WL = (bf16*)(p.ws + WS_WL);
  const int total = 768 + 256 + 16 + 256 + 256 + 512 + 256 + 256 + 256 + 128;
  for (int T = blockIdx.x; T < total; T += gridDim.x) {
    int x = T;
    if (x < 768) { tr_tile(IN(11), 6176, 0, 3072, WA, 1024, x & 15, x >> 4); continue; }
    x -= 768;
    if (x < 256) { tr_tile(IN(11), 6176, 4096, 1024, WA + (size_t)3072 * 1024, 1024, x & 15, x >> 4); continue; }
    x -= 256;
    if (x < 16) { tr_tile(IN(11), 6176, 6144, 32, WA + (size_t)4096 * 1024, 1024, x & 15, 0); continue; }
    x -= 16;
    if (x < 256) { tr_tile(IN(11), 6176, 3072, 1024, WB, 1024, x & 15, x >> 4); continue; }
    x -= 256;
    if (x < 256) { tr_tile(IN(11), 6176, 5120, 1024, WB + (size_t)1024 * 1024, 1024, x & 15, x >> 4); continue; }
    x -= 256;
    if (x < 512) { tr_tile(IN(33), 2048, 0, 2048, WB + (size_t)2048 * 1024, 1024, x & 15, x >> 4); continue; }
    x -= 512;
    if (x < 256) { tr_tile(IN(31), 1024, 0, 1024, WPA, 2048, x & 15, x >> 4); continue; }
    x -= 256;
    if (x < 256) { tr_tile(IN(32), 1024, 0, 1024, WPB, 2048, x & 15, x >> 4); continue; }
    x -= 256;
    if (x < 256) {
      tr_tile(IN(35), 1024, 0, 1024, WOUT, 2048, x & 15, x >> 4);
      tr_tile(IN(35), 1024, 0, 1024, WOUT + 1024, 2048, x & 15, x >> 4);
      continue;
    }
    x -= 256;
    {
      int sub = x >> 2, tt = x & 3;
      int type = sub >> 3, blk = sub & 7;
      const int widx[4] = {21, 23, 26, 28};
      const float* src = IN(type == 0 ? 21 : type == 1 ? 23 : type == 2 ? 26 : 28) + (size_t)blk * 128 * 128;
      (void)widx;
      tr_tile(src, 128, 0, 128, WL + ((size_t)blk * 512 + type * 128) * 128, 128, tt & 1, tt >> 1);
    }
  }
  {
    uint4 z = make_uint4(0, 0, 0, 0);
    uint4* dst = (uint4*)(WA + (size_t)4128 * 1024);
    const int n16 = 224 * 1024 * 2 / 16;
    for (int i = blockIdx.x * 512 + tid_l(); i < n16; i += gridDim.x * 512) dst[i] = z;
  }
}

__device__ void phase_h(const Params& p, bf16* H) {
  const int t_ = tid_l();
  const int lane = t_ & 63, wv = t_ >> 6;
  const float* nw = IN(8);
  const float* mod = (const float*)(p.ws + WS_MOD);
  auto process = [&](int R, const float4 (&v)[4]) {
    float ss = 0.f;
#pragma unroll
    for (int i = 0; i < 4; ++i) ss += v[i].x * v[i].x + v[i].y * v[i].y + v[i].z * v[i].z + v[i].w * v[i].w;
    for (int o = 32; o > 0; o >>= 1) ss += shfl_lane(ss, lane ^ o);
    const float rstd = rsqrtf(ss * (1.f / 1024.f) + 1e-6f);
    const float* md = mod + modidx(R) * 3072;
#pragma unroll
    for (int i = 0; i < 4; ++i) {
      const int c = (lane + 64 * i) * 4;
      float4 w4 = *(const float4*)(nw + c);
      float4 sh = *(const float4*)(md + c);
      float4 scl = *(const float4*)(md + 1024 + c);
      float h0 = v[i].x * rstd * w4.x * (1.f + scl.x) + sh.x;
      float h1 = v[i].y * rstd * w4.y * (1.f + scl.y) + sh.y;
      float h2 = v[i].z * rstd * w4.z * (1.f + scl.z) + sh.z;
      float h3 = v[i].w * rstd * w4.w * (1.f + scl.w) + sh.w;
      uint2 o;
      o.x = pack2(h0, h1);
      o.y = pack2(h2, h3);
      *(uint2*)(H + (size_t)R * 1024 + c) = o;
    }
  };
  const int stride = gridDim.x * 8;
  for (int R = blockIdx.x * 8 + wv; R < NTOK; R += 2 * stride) {
    const int R2 = R + stride;
    const bool has2 = R2 < NTOK;
    const float4* xa = (const float4*)xrow(p, R);
    const float4* xb2 = (const float4*)xrow(p, has2 ? R2 : R);
    float4 v[4], u[4];
#pragma unroll
    for (int i = 0; i < 4; ++i) v[i] = xa[lane + 64 * i];
#pragma unroll
    for (int i = 0; i < 4; ++i) u[i] = xb2[lane + 64 * i];
    process(R, v);
    if (has2) process(R2, u);
  }
}

__device__ __forceinline__ uint2 pack4(float a, float b, float c, float d) {
  uint2 o;
  o.x = pack2(a, b);
  o.y = pack2(c, d);
  return o;
}

__device__ void phase_gemm1a(const Params& p, const bf16* H, int g, int first, int stride) {
  const bf16* WA = (const bf16*)(p.ws + WS_WA);
  us* QKV = (us*)(p.ws + WS_QKV);
  us* XB = (us*)(p.ws + ((g & 1) ? WS_XB2 : WS_XB));
  float* GC = (float*)(p.ws + WS_GC);
  for (int T = first; T < 20 * 17; T += stride) {
    const int tm = T % 20, tn = T / 20;
    const int r0 = tm * 256, R0 = grow(g, r0);
    f32x4 acc[2][2][4][2];
    zero_acc(acc);
    gemm_tile(H + (size_t)R0 * 1024, 1024, WA + (size_t)tn * 256 * 1024, 1024, 1024, acc);
    if (tn < 12) {
      epilogue(acc, [&](int row, int c4, float4 v) {
        *(uint2*)(QKV + (size_t)(r0 + row) * 3072 + tn * 256 + c4) = pack4(v.x, v.y, v.z, v.w);
      });
    } else if (tn < 16) {
      epilogue(acc, [&](int row, int c4, float4 v) {
        *(uint2*)(XB + (size_t)(r0 + row) * 1024 + (tn - 12) * 256 + c4) = pack4(v.x, v.y, v.z, v.w);
      });
    } else {
      epilogue(acc, [&](int row, int c4, float4 v) {
        if (c4 < 32) *(float4*)(GC + (size_t)(r0 + row) * 32 + c4) = v;
      });
    }
  }
}

__device__ void phase_gemm1b(const Params& p, const bf16* H, int first, int stride, int mode) {
  const bf16* WB = (const bf16*)(p.ws + WS_WB);
  us* OCAT = (us*)(p.ws + WS_OCAT);
  us* GATE = (us*)(p.ws + WS_GATE);
  const float* bg = IN(34);
  const int ntile = mode == 0 ? 36 * 16 : 44 * 16;
  for (int T = first; T < ntile; T += stride) {
    const int tmi = T >> 4, tn = T & 15;
    const int tm = mode == 0 ? (tmi < 12 ? tmi : tmi + 4) : (tmi < 4 ? 12 + tmi : 36 + tmi);
    const int R0 = tm * 256;
    f32x4 acc[2][2][4][2];
    zero_acc(acc);
    gemm_tile(H + (size_t)R0 * 1024, 1024, WB + (size_t)tn * 256 * 1024, 1024, 1024, acc);
    epilogue(acc, [&](int row, int c4, float4 v) {
      if (tn < 8) {
        uint2* ptr = (uint2*)(OCAT + (size_t)(R0 + row) * 2048 + tn * 256 + c4);
        const uint2 o = *ptr;
        *ptr = pack4(__uint_as_float(o.x << 16) * siluf_(v.x), __uint_as_float(o.x & 0xffff0000u) * siluf_(v.y),
                     __uint_as_float(o.y << 16) * siluf_(v.z), __uint_as_float(o.y & 0xffff0000u) * siluf_(v.w));
      } else {
        const int gc = (tn - 8) * 256 + c4;
        const float4 b4 = *(const float4*)(bg + gc);
        *(uint2*)(GATE + (size_t)(R0 + row) * 2048 + gc) =
            pack4(sigmoidf_(v.x + b4.x), sigmoidf_(v.y + b4.y), sigmoidf_(v.z + b4.z), sigmoidf_(v.w + b4.w));
      }
    });
  }
}

__device__ void phase_gemm3(const Params& p, int T, int half) {
  const bf16* OCAT = (const bf16*)(p.ws + WS_OCAT);
  const bf16* WPA = (const bf16*)(p.ws + WS_WPA);
  const bf16* WPB = (const bf16*)(p.ws + WS_WPB);
  us* GATE = (us*)(p.ws + WS_GATE);
  {
    const int tm = T >> 2, tn = T & 3;
    const int R0 = tm * 256;
    {
      f32x4 acc[2][2][4][2];
      zero_acc(acc);
      const bf16* A = OCAT + (size_t)R0 * 2048 + half * 1024;
      const bf16* Bt = (half ? WPB : WPA) + (size_t)tn * 256 * 2048;
      gemm_tile(A, 2048, Bt, 2048, 1024, acc);
      epilogue(acc, [&](int row, int c4, float4 v) {
        us* base = GATE + (size_t)(R0 + row) * 2048 + tn * 256 + c4;
        const uint2 g = *(const uint2*)(base + half * 1024);
        float r0 = __uint_as_float(g.x << 16) * v.x, r1 = __uint_as_float(g.x & 0xffff0000u) * v.y;
        float r2 = __uint_as_float(g.y << 16) * v.z, r3 = __uint_as_float(g.y & 0xffff0000u) * v.w;
        if (half) {
          const uint2 m = *(const uint2*)base;
          r0 += __uint_as_float(m.x << 16); r1 += __uint_as_float(m.x & 0xffff0000u);
          r2 += __uint_as_float(m.y << 16); r3 += __uint_as_float(m.y & 0xffff0000u);
        }
        const uint2 pk = pack4(r0, r1, r2, r3);
        __hip_atomic_store((unsigned long long*)base, ((unsigned long long)pk.y << 32) | pk.x, __ATOMIC_RELAXED, __HIP_MEMORY_SCOPE_AGENT);
      });
    }
  }
}

__device__ void phase_gemm4(const Params& p, int first, int stride) {
  const bf16* TT = (const bf16*)(p.ws + WS_GATE);
  const bf16* WOUT2 = (const bf16*)(p.ws + WS_WOUT);
  const float* mod = (const float*)(p.ws + WS_MOD);
  for (int T = first; T < 80 * 4; T += stride) {
    const int tm = T >> 2, tn = T & 3;
    const int R0 = tm * 256, c0 = tn * 256;
    f32x4 acc[2][2][4][2];
    zero_acc(acc);
    gemm_tile(TT + (size_t)R0 * 2048, 2048, WOUT2 + (size_t)c0 * 2048, 2048, 1024, acc);
    const float* md = mod + modidx(R0) * 3072 + 2048;
    const float* xr = xrow(p, R0);
    epilogue(acc, [&](int row, int c4, float4 v) {
      const int c = c0 + c4;
      const float4 xv = *(const float4*)(xr + (size_t)row * 1024 + c);
      const float4 m4 = *(const float4*)(md + c);
      float4 o;
      o.x = xv.x + m4.x * v.x;
      o.y = xv.y + m4.y * v.y;
      o.z = xv.z + m4.z * v.z;
      o.w = xv.w + m4.w * v.w;
      *(float4*)(p.out + (size_t)(R0 + row) * 1024 + c) = o;
    });
  }
}

__device__ void phase_final(const Params& p) {
  const int t_ = tid_l();
  const int lane = t_ & 63, wv = t_ >> 6;
  const float* fw = IN(36);
  auto process = [&](int R, const float4 (&v)[4]) {
    float4* x4 = (float4*)(p.out + (size_t)R * 1024);
    float ss = 0.f;
#pragma unroll
    for (int i = 0; i < 4; ++i) ss += v[i].x * v[i].x + v[i].y * v[i].y + v[i].z * v[i].z + v[i].w * v[i].w;
    for (int o = 32; o > 0; o >>= 1) ss += shfl_lane(ss, lane ^ o);
    const float rstd = rsqrtf(ss * (1.f / 1024.f) + 1e-6f);
#pragma unroll
    for (int i = 0; i < 4; ++i) {
      float4 w4 = *(const float4*)(fw + (lane + 64 * i) * 4);
      float4 o;
      o.x = v[i].x * rstd * w4.x;
      o.y = v[i].y * rstd * w4.y;
      o.z = v[i].z * rstd * w4.z;
      o.w = v[i].w * rstd * w4.w;
      x4[lane + 64 * i] = o;
    }
  };
  const int stride = gridDim.x * 8;
  for (int R = blockIdx.x * 8 + wv; R < NTOK; R += 2 * stride) {
    const int R2 = R + stride;
    const bool has2 = R2 < NTOK;
    const float4* xa = (const float4*)(p.out + (size_t)R * 1024);
    const float4* xb2 = (const float4*)(p.out + (size_t)(has2 ? R2 : R) * 1024);
    float4 v[4], u[4];
#pragma unroll
    for (int i = 0; i < 4; ++i) v[i] = xa[lane + 64 * i];
#pragma unroll
    for (int i = 0; i < 4; ++i) u[i] = xb2[lane + 64 * i];
    process(R, v);
    if (has2) process(R2, u);
  }
}

#if PROBE_MASK
#define PTICK(B) { long long tq1_ = wall_clock64(); if ((PROBE_MASK >> (B)) & 1) tacc += tq1_ - tq0_; tq0_ = tq1_; }
#define PT0() long long tq0_ = wall_clock64();
#else
#define PTICK(B)
#define PT0()
#endif
__device__ __forceinline__ bf16x8 ld8(const us* ptr) { return *reinterpret_cast<const bf16x8*>(ptr); }

__device__ void gdn_prep_item(const Params& p, int item, long long& tacc) {
  PT0()
  const int t = tid_l(), lane = t & 63, w = t >> 6;
  const int tc = item >> 3, h = item & 7;
  const int r0 = tc * 64;
  int seq_lo, seq_hi;
  if (tc < 16) { seq_lo = (tc >> 2) * 256; seq_hi = seq_lo + 256; } else { seq_lo = 1024; seq_hi = 5120; }
  const int ci = item;

  char* L = (char*)shm;
  us* qs = (us*)L;
  us* ks = (us*)(L + 17408);
  float* AF = (float*)L;
  float* ABF = (float*)(L + 17408);
  us* kTb = (us*)(L + 34816);
  us* vTb = (us*)(L + 53248);
  float* vec = (float*)(L + 71680);
  float* Gv = vec;
  float* Bv = vec + 128;
  float* SCL = vec + 256;

  const us* QKV = (const us*)(p.ws + WS_QKV);
  const float* GC = (const float*)(p.ws + WS_GC);

  float* cwl2 = (float*)(L + 131072);
  if (t < 480) {
    const int rw = t / 96, rem = t - rw * 96, m = rem >> 5, c4 = (rem & 31) * 4;
    const float* srcw = rw < 4 ? IN(12) + rw * 3072 + m * 1024 + h * 128 + c4 : IN(13) + m * 1024 + h * 128 + c4;
    *(float4*)(cwl2 + rw * 384 + m * 128 + c4) = *(const float4*)srcw;
  }
  if (w == 0) {
    const int i = lane;
    const float* gc = GC + (size_t)(r0 + i) * 32;
    float af = gc[h], bfv = gc[8 + h], ab = gc[16 + h], bb = gc[24 + h];
    float gf = -__expf(IN(14)[h]) * softplusf_(af + IN(15)[h]);
    float gb = -__expf(IN(16)[h]) * softplusf_(ab + IN(17)[h]);
    float betaf = sigmoidf_(bfv), betab = sigmoidf_(bb);
    float s = gf;
    for (int o = 1; o < 64; o <<= 1) {
      float y = shfl_lane(s, lane >= o ? lane - o : lane);
      if (lane >= o) s += y;
    }
    float s2 = gb;
    for (int o = 1; o < 64; o <<= 1) {
      float y = shfl_lane(s2, lane + o < 64 ? lane + o : lane);
      if (lane + o < 64) s2 += y;
    }
    float glf = shfl_lane(s, 63), glb = shfl_lane(s2, 0);
    Gv[i] = s; Gv[64 + i] = s2;
    Bv[i] = betaf; Bv[64 + i] = betab;
    float egf = __expf(s), egb = __expf(s2);
    SCL[i] = betaf; SCL[64 + i] = betaf * egf; SCL[128 + i] = betab; SCL[192 + i] = betab * egb;
    float* EG = (float*)(p.ws + WS_EG);
    float* ES = (float*)(p.ws + WS_ES);
    float* DL = (float*)(p.ws + WS_DL);
    EG[(size_t)(ci * 2 + 0) * 64 + i] = egf;
    EG[(size_t)(ci * 2 + 1) * 64 + i] = egb;
    ES[(size_t)(ci * 2 + 0) * 64 + i] = __expf(glf - s);
    ES[(size_t)(ci * 2 + 1) * 64 + i] = __expf(glb - s2);
    if (i == 0) { DL[ci * 2 + 0] = __expf(glf); DL[ci * 2 + 1] = __expf(glb); }
  }
  lds_barrier();
  {
    const int i = t >> 3, cg8 = t & 7;
#pragma unroll
    for (int m = 0; m < 3; ++m) {
      const int col = m * 1024 + h * 128 + cg8 * 16;
      const float* cwm = cwl2 + m * 128 + cg8 * 16;
      float y[16];
#pragma unroll
      for (int c = 0; c < 16; ++c) y[c] = cwm[4 * 384 + c];
#pragma unroll
      for (int tap = 0; tap < 4; ++tap) {
        const int rr = r0 + i - 2 + tap;
        if (rr >= seq_lo && rr < seq_hi) {
          const uint4* src = (const uint4*)(QKV + (size_t)rr * 3072 + col);
          uint4 a = src[0], b = src[1];
          unsigned wds[8] = {a.x, a.y, a.z, a.w, b.x, b.y, b.z, b.w};
          const float* wt = cwm + tap * 384;
#pragma unroll
          for (int c = 0; c < 8; ++c) {
            y[2 * c] += wt[2 * c] * __uint_as_float(wds[c] << 16);
            y[2 * c + 1] += wt[2 * c + 1] * __uint_as_float(wds[c] & 0xffff0000u);
          }
        }
      }
      float ss = 0.f;
#pragma unroll
      for (int c = 0; c < 16; ++c) { y[c] = siluf_(y[c]); ss += y[c] * y[c]; }
      if (m < 2) {
        ss += shfl_lane(ss, lane ^ 1);
        ss += shfl_lane(ss, lane ^ 2);
        ss += shfl_lane(ss, lane ^ 4);
        float inv = rsqrtf(ss + 1e-6f);
        if (m == 0) inv *= 0.08838834764831845f;
#pragma unroll
        for (int c = 0; c < 16; ++c) y[c] *= inv;
      }
      if (m == 0) {
        uint4 o0, o1;
        o0.x = pack2(y[0], y[1]); o0.y = pack2(y[2], y[3]); o0.z = pack2(y[4], y[5]); o0.w = pack2(y[6], y[7]);
        o1.x = pack2(y[8], y[9]); o1.y = pack2(y[10], y[11]); o1.z = pack2(y[12], y[13]); o1.w = pack2(y[14], y[15]);
        *(uint4*)(qs + i * 136 + cg8 * 16) = o0;
        *(uint4*)(qs + i * 136 + cg8 * 16 + 8) = o1;
        us* Qg = (us*)(p.ws + WS_Q) + (size_t)ci * 8192 + i * 128 + cg8 * 16;
        *(uint4*)Qg = o0;
        *(uint4*)(Qg + 8) = o1;
      } else if (m == 1) {
        uint4 o0, o1;
        o0.x = pack2(y[0], y[1]); o0.y = pack2(y[2], y[3]); o0.z = pack2(y[4], y[5]); o0.w = pack2(y[6], y[7]);
        o1.x = pack2(y[8], y[9]); o1.y = pack2(y[10], y[11]); o1.z = pack2(y[12], y[13]); o1.w = pack2(y[14], y[15]);
        *(uint4*)(ks + i * 136 + cg8 * 16) = o0;
        *(uint4*)(ks + i * 136 + cg8 * 16 + 8) = o1;
#pragma unroll
        for (int c = 0; c < 16; ++c) kTb[(cg8 * 16 + c) * 72 + i] = f2bf(y[c]);
      } else {
#pragma unroll
        for (int c = 0; c < 16; ++c) vTb[(cg8 * 16 + c) * 72 + i] = f2bf(y[c]);
      }
    }
  }
  lds_barrier();
  PTICK(13)
  f32x4 acc[4];
  {
    const int mat = w >> 2, mt = w & 3;
    const us* Asrc = mat == 0 ? ks : qs;
#pragma unroll
    for (int n = 0; n < 4; ++n) acc[n] = f32x4{0.f, 0.f, 0.f, 0.f};
#pragma unroll
    for (int kk = 0; kk < 4; ++kk) {
      bf16x8 a = ld8(Asrc + (16 * mt + (lane & 15)) * 136 + kk * 32 + (lane >> 4) * 8);
#pragma unroll
      for (int n = 0; n < 4; ++n) {
        bf16x8 b = ld8(ks + (16 * n + (lane & 15)) * 136 + kk * 32 + (lane >> 4) * 8);
        acc[n] = __builtin_amdgcn_mfma_f32_16x16x32_bf16(a, b, acc[n], 0, 0, 0);
      }
    }
  }
  lds_barrier();
  {
    const int mat = w >> 2, mt = w & 3;
    us* QKM = (us*)(p.ws + WS_QKM);
#pragma unroll
    for (int n = 0; n < 4; ++n)
#pragma unroll
      for (int jj = 0; jj < 4; ++jj) {
        const int i = 16 * mt + 4 * (lane >> 4) + jj, j = 16 * n + (lane & 15);
        const float val = acc[n][jj];
        const float df = __expf(Gv[i] - Gv[j]);
        const float db = __expf(Gv[64 + i] - Gv[64 + j]);
        if (mat == 0) {
          AF[i * 68 + j] = (i > j) ? Bv[i] * val * df : 0.f;
          ABF[(63 - i) * 68 + (63 - j)] = (i < j) ? Bv[64 + i] * val * db : 0.f;
        } else {
          QKM[(size_t)(ci * 2 + 0) * 4096 + i * 64 + j] = f2bf((i >= j) ? val * df : 0.f);
          QKM[(size_t)(ci * 2 + 1) * 4096 + i * 64 + j] = f2bf((i <= j) ? val * db : 0.f);
        }
      }
  }
  {
    us* KT = (us*)(p.ws + WS_KT) + (size_t)ci * 8192;
    for (int idx = t; idx < 8192; idx += 512) KT[idx] = kTb[(idx >> 6) * 72 + (idx & 63)];
  }
  lds_barrier();
  PTICK(14)
  {
    const int d = w >> 2, wq = w & 3, lr = lane & 15, lq = lane >> 4;
    const float* Am = d ? ABF : AF;
    us* Sm = (us*)(L + 73728 + d * 27648);
    us* STm = Sm + 4608;
    us* Pm = STm + 4608;
    f32x4 Pacc[4], Sn[4];
#pragma unroll
    for (int nt = 0; nt < 4; ++nt)
#pragma unroll
      for (int jj = 0; jj < 4; ++jj) {
        const int row = 16 * wq + 4 * lq + jj, col = 16 * nt + lr;
        const float av = Am[row * 68 + col];
        Sn[nt][jj] = av;
        Pacc[nt][jj] = (row == col ? 1.f : 0.f) - av;
      }
    auto write_S = [&]() {
#pragma unroll
      for (int nt = 0; nt < 4; ++nt) {
        const int col = 16 * nt + lr, row0 = 16 * wq + 4 * lq;
#pragma unroll
        for (int jj = 0; jj < 4; ++jj) Sm[(row0 + jj) * 72 + col] = f2bf(Sn[nt][jj]);
        uint2 o;
        o.x = pack2(Sn[nt][0], Sn[nt][1]);
        o.y = pack2(Sn[nt][2], Sn[nt][3]);
        *(uint2*)(STm + col * 72 + row0) = o;
      }
    };
    auto write_P = [&]() {
#pragma unroll
      for (int nt = 0; nt < 4; ++nt) {
        const int col = 16 * nt + lr, row0 = 16 * wq + 4 * lq;
#pragma unroll
        for (int jj = 0; jj < 4; ++jj) Pm[(row0 + jj) * 72 + col] = f2bf(Pacc[nt][jj]);
      }
    };
    write_S();
    write_P();
    lds_barrier();
    {
      f32x4 acc2[4];
#pragma unroll
      for (int nt = 0; nt < 4; ++nt) acc2[nt] = f32x4{0.f, 0.f, 0.f, 0.f};
#pragma unroll
      for (int kk = 0; kk < 2; ++kk) {
        bf16x8 af = ld8(Sm + (16 * wq + lr) * 72 + kk * 32 + lq * 8);
#pragma unroll
        for (int nt = 0; nt < 4; ++nt) {
          bf16x8 bfr = ld8(STm + (16 * nt + lr) * 72 + kk * 32 + lq * 8);
          acc2[nt] = __builtin_amdgcn_mfma_f32_16x16x32_bf16(af, bfr, acc2[nt], 0, 0, 0);
        }
      }
#pragma unroll
      for (int nt = 0; nt < 4; ++nt) Sn[nt] = acc2[nt];
    }
    lds_barrier();
    write_S();
#pragma unroll 1
    for (int k = 1; k <= 5; ++k) {
      lds_barrier();
      f32x4 acc2[4];
#pragma unroll
      for (int nt = 0; nt < 4; ++nt) acc2[nt] = f32x4{0.f, 0.f, 0.f, 0.f};
#pragma unroll
      for (int kk = 0; kk < 2; ++kk) {
        bf16x8 pf = ld8(Pm + (16 * wq + lr) * 72 + kk * 32 + lq * 8);
        bf16x8 sf = ld8(Sm + (16 * wq + lr) * 72 + kk * 32 + lq * 8);
#pragma unroll
        for (int nt = 0; nt < 4; ++nt) {
          bf16x8 bfr = ld8(STm + (16 * nt + lr) * 72 + kk * 32 + lq * 8);
          Pacc[nt] = __builtin_amdgcn_mfma_f32_16x16x32_bf16(pf, bfr, Pacc[nt], 0, 0, 0);
          acc2[nt] = __builtin_amdgcn_mfma_f32_16x16x32_bf16(sf, bfr, acc2[nt], 0, 0, 0);
        }
      }
#pragma unroll
      for (int nt = 0; nt < 4; ++nt) Sn[nt] = acc2[nt];
      lds_barrier();
      if (k < 5) {
        write_S();
        write_P();
      }
    }
    {
#pragma unroll
      for (int nt = 0; nt < 4; ++nt)
#pragma unroll
        for (int jj = 0; jj < 4; ++jj) {
          Pacc[nt][jj] = bf2f(f2bf(Pacc[nt][jj]));
          Sn[nt][jj] = Pacc[nt][jj];
        }
      write_S();
      lds_barrier();
      f32x4 Racc[4];
#pragma unroll
      for (int nt = 0; nt < 4; ++nt)
#pragma unroll
        for (int jj = 0; jj < 4; ++jj) Racc[nt][jj] = ((16 * wq + 4 * lq + jj) == (16 * nt + lr)) ? 1.f : 0.f;
#pragma unroll
      for (int kk = 0; kk < 2; ++kk) {
        const int rr = 16 * wq + lr, k0 = kk * 32 + lq * 8;
        const float* ar = Am + rr * 68 + k0;
        bf16x8 hi, lo;
#pragma unroll
        for (int e = 0; e < 8; ++e) {
          const float lv = -(ar[e] + (rr == k0 + e ? 1.f : 0.f));
          const us hb = f2bf(lv);
          hi[e] = (short)hb;
          lo[e] = (short)f2bf(lv - bf2f(hb));
        }
#pragma unroll
        for (int nt = 0; nt < 4; ++nt) {
          bf16x8 bfr = ld8(STm + (16 * nt + lr) * 72 + kk * 32 + lq * 8);
          Racc[nt] = __builtin_amdgcn_mfma_f32_16x16x32_bf16(hi, bfr, Racc[nt], 0, 0, 0);
          Racc[nt] = __builtin_amdgcn_mfma_f32_16x16x32_bf16(lo, bfr, Racc[nt], 0, 0, 0);
        }
      }
#pragma unroll
      for (int nt = 0; nt < 4; ++nt) {
        uint2 o;
        o.x = pack2(Racc[nt][0], Racc[nt][1]);
        o.y = pack2(Racc[nt][2], Racc[nt][3]);
        *(uint2*)(Pm + (16 * nt + lr) * 72 + 16 * wq + 4 * lq) = o;
      }
      lds_barrier();
#pragma unroll
      for (int kk = 0; kk < 2; ++kk) {
        bf16x8 af = ld8(Sm + (16 * wq + lr) * 72 + kk * 32 + lq * 8);
#pragma unroll
        for (int nt = 0; nt < 4; ++nt) {
          bf16x8 bfr = ld8(Pm + (16 * nt + lr) * 72 + kk * 32 + lq * 8);
          Pacc[nt] = __builtin_amdgcn_mfma_f32_16x16x32_bf16(af, bfr, Pacc[nt], 0, 0, 0);
        }
      }
      lds_barrier();
    }
    {
      const float* sclU = SCL + (d * 2 + 0) * 64;
      const float* sclW = SCL + (d * 2 + 1) * 64;
#pragma unroll
      for (int nt = 0; nt < 4; ++nt)
#pragma unroll
        for (int jj = 0; jj < 4; ++jj) {
          const int ip = 16 * wq + 4 * lq + jj, jp = 16 * nt + lr;
          const int i = d ? 63 - ip : ip, j = d ? 63 - jp : jp;
          const float tv = Pacc[nt][jj];
          Sm[i * 72 + j] = f2bf(tv * sclU[j]);
          STm[i * 72 + j] = f2bf(tv * sclW[j]);
        }
    }
    lds_barrier();
    PTICK(15)
#pragma unroll 1
    for (int isW = 0; isW < 2; ++isW) {
      const us* Tm = isW ? STm : Sm;
      const us* Bm = isW ? kTb : vTb;
      f32x4 accU[8];
#pragma unroll
      for (int nt = 0; nt < 8; ++nt) accU[nt] = f32x4{0.f, 0.f, 0.f, 0.f};
#pragma unroll
      for (int kk = 0; kk < 2; ++kk) {
        bf16x8 af = ld8(Tm + (16 * wq + lr) * 72 + kk * 32 + lq * 8);
#pragma unroll
        for (int nt = 0; nt < 8; ++nt) {
          bf16x8 bfr = ld8(Bm + (16 * nt + lr) * 72 + kk * 32 + lq * 8);
          accU[nt] = __builtin_amdgcn_mfma_f32_16x16x32_bf16(af, bfr, accU[nt], 0, 0, 0);
        }
      }
      us* dst = (us*)(p.ws + (isW ? WS_WN : WS_U)) + (size_t)(ci * 2 + d) * 8192;
      if (isW) {
#pragma unroll
        for (int nt = 0; nt < 8; ++nt)
#pragma unroll
          for (int jj = 0; jj < 4; ++jj) dst[(16 * wq + 4 * lq + jj) * 128 + 16 * nt + lr] = f2bf(-accU[nt][jj]);
      } else {
#pragma unroll
        for (int sl2 = 0; sl2 < 4; ++sl2) {
          uint4 o;
          o.x = pack2(accU[2 * sl2][0], accU[2 * sl2][1]);
          o.y = pack2(accU[2 * sl2][2], accU[2 * sl2][3]);
          o.z = pack2(accU[2 * sl2 + 1][0], accU[2 * sl2 + 1][1]);
          o.w = pack2(accU[2 * sl2 + 1][2], accU[2 * sl2 + 1][3]);
          *(uint4*)(dst + ((sl2 * 4 + wq) * 64 + lane) * 8) = o;
        }
      }
    }
  }
  lds_barrier();
  PTICK(16)
}

__device__ void gdn_seq_item(const Params& p, int g, int item, us* OF, us* OB) {
  const int t = tid_l(), lane = t & 63, w = __builtin_amdgcn_readfirstlane(t >> 6);
  int h, d, sl, tc0, nch, seq = -1;
  if (item < 64) { h = item >> 3; d = (item >> 2) & 1; sl = item & 3; tc0 = 16; nch = 64; }
  else { int it = item - 64; seq = it >> 6; int rem = it & 63; h = rem >> 3; d = (rem >> 2) & 1; sl = rem & 3; tc0 = seq * 4; nch = 4; }
  char* L = (char*)shm;
  us* sT = (us*)L;
  us* vT = (us*)(L + 8704);
  us* vsT = (us*)(L + 8704 + 4608);
  const us* Qb = (const us*)(p.ws + WS_Q);
  const us* KTb = (const us*)(p.ws + WS_KT);
  const us* WNb = (const us*)(p.ws + WS_WN);
  const us* Ub = (const us*)(p.ws + WS_U);
  const us* QKMb = (const us*)(p.ws + WS_QKM);
  const float* EG = (const float*)(p.ws + WS_EG);
  const float* ES = (const float*)(p.ws + WS_ES);
  const float* DL = (const float*)(p.ws + WS_DL);
  us* O = d ? OB : OF;
  const int lr = lane & 15, lq = lane >> 4;

  f32x4 s[2];
  if (seq < 0) {
    const float* st = IN(d ? 3 : 2) + ((size_t)(g * 8 + h) * 128) * 128;
#pragma unroll
    for (int nt = 0; nt < 2; ++nt)
#pragma unroll
      for (int jj = 0; jj < 4; ++jj) s[nt][jj] = st[(size_t)(16 * w + 4 * lq + jj) * 128 + sl * 32 + 16 * nt + lr];
  } else {
    s[0] = f32x4{0.f, 0.f, 0.f, 0.f};
    s[1] = f32x4{0.f, 0.f, 0.f, 0.f};
  }
  lds_barrier();
#pragma unroll
  for (int nt = 0; nt < 2; ++nt) {
    uint2 o;
    o.x = pack2(s[nt][0], s[nt][1]);
    o.y = pack2(s[nt][2], s[nt][3]);
    *(uint2*)(sT + (16 * nt + lr) * 136 + 16 * w + 4 * lq) = o;
  }
  lds_barrier();

  struct Ops {
    bf16x8 a[4];
    bf16x8 qk[2];
    bf16x8 kt[2];
    uint4 u;
    float e[4];
    float dl;
  };
  const int mt = w & 3;
  auto load_a = [&](int step, Ops& o) {
    const int c = d ? nch - 1 - step : step;
    const int tc = tc0 + c;
    const int ci = tc * 8 + h, cd = ci * 2 + d;
    const us* Ap = (w < 4) ? (WNb + (size_t)cd * 8192) : (Qb + (size_t)ci * 8192);
#pragma unroll
    for (int kk = 0; kk < 4; ++kk) o.a[kk] = ld8(Ap + (16 * mt + lr) * 128 + kk * 32 + lq * 8);
    if (w < 4) {
      o.u = *(const uint4*)(Ub + (size_t)cd * 8192 + ((sl * 4 + mt) * 64 + lane) * 8);
      const float4 e4 = *(const float4*)(ES + (size_t)cd * 64 + 16 * mt + 4 * lq);
      o.e[0] = e4.x; o.e[1] = e4.y; o.e[2] = e4.z; o.e[3] = e4.w;
    } else {
      const float4 e4 = *(const float4*)(EG + (size_t)cd * 64 + 16 * mt + 4 * lq);
      o.e[0] = e4.x; o.e[1] = e4.y; o.e[2] = e4.z; o.e[3] = e4.w;
    }
  };
  auto load_b = [&](int step, Ops& o) {
    const int c = d ? nch - 1 - step : step;
    const int tc = tc0 + c;
    const int ci = tc * 8 + h, cd = ci * 2 + d;
    const us* Kp = KTb + (size_t)ci * 8192;
#pragma unroll
    for (int kk = 0; kk < 2; ++kk) o.kt[kk] = ld8(Kp + (16 * w + lr) * 64 + kk * 32 + lq * 8);
    o.dl = DL[cd];
    if (w >= 4) {
      const us* Qp = QKMb + (size_t)cd * 4096;
#pragma unroll
      for (int kk = 0; kk < 2; ++kk) o.qk[kk] = ld8(Qp + (16 * mt + lr) * 64 + kk * 32 + lq * 8);
    }
  };
  Ops ring[4];
  load_a(0, ring[0]); load_b(0, ring[0]);
  load_a(1, ring[1]); load_b(1, ring[1]);
  load_a(2, ring[2]); load_b(2, ring[2]);
  auto do_step = [&](int step, int tc, int nstep, auto STc) {
    constexpr int ST = decltype(STc)::value;
    f32x4 acc[2];
    {
      if (w < 4) {
        const uint4 uu = ring[ST].u;
        acc[0][0] = __uint_as_float(uu.x << 16); acc[0][1] = __uint_as_float(uu.x & 0xffff0000u);
        acc[0][2] = __uint_as_float(uu.y << 16); acc[0][3] = __uint_as_float(uu.y & 0xffff0000u);
        acc[1][0] = __uint_as_float(uu.z << 16); acc[1][1] = __uint_as_float(uu.z & 0xffff0000u);
        acc[1][2] = __uint_as_float(uu.w << 16); acc[1][3] = __uint_as_float(uu.w & 0xffff0000u);
      } else {
        acc[0] = f32x4{0.f, 0.f, 0.f, 0.f};
        acc[1] = f32x4{0.f, 0.f, 0.f, 0.f};
      }
#pragma unroll
      for (int kk = 0; kk < 4; ++kk)
#pragma unroll
        for (int nt = 0; nt < 2; ++nt) {
          bf16x8 b = ld8(sT + (16 * nt + lr) * 136 + kk * 32 + lq * 8);
          acc[nt] = __builtin_amdgcn_mfma_f32_16x16x32_bf16(ring[ST].a[kk], b, acc[nt], 0, 0, 0);
        }
    }
    if (w < 4) {
#pragma unroll
      for (int nt = 0; nt < 2; ++nt) {
        uint2 o, o2;
        o.x = pack2(acc[nt][0], acc[nt][1]);
        o.y = pack2(acc[nt][2], acc[nt][3]);
        o2.x = pack2(acc[nt][0] * ring[ST].e[0], acc[nt][1] * ring[ST].e[1]);
        o2.y = pack2(acc[nt][2] * ring[ST].e[2], acc[nt][3] * ring[ST].e[3]);
        *(uint2*)(vT + (16 * nt + lr) * 72 + 16 * mt + 4 * lq) = o;
        *(uint2*)(vsT + (16 * nt + lr) * 72 + 16 * mt + 4 * lq) = o2;
      }
    }
    lds_barrier();
    load_b(nstep, ring[(ST + 3) & 3]);
    if (w >= 4) {
#pragma unroll
      for (int nt = 0; nt < 2; ++nt)
#pragma unroll
        for (int jj = 0; jj < 4; ++jj) acc[nt][jj] *= ring[ST].e[jj];
#pragma unroll
      for (int kk = 0; kk < 2; ++kk) {
#pragma unroll
        for (int nt = 0; nt < 2; ++nt) {
          bf16x8 b = ld8(vT + (16 * nt + lr) * 72 + kk * 32 + lq * 8);
          acc[nt] = __builtin_amdgcn_mfma_f32_16x16x32_bf16(ring[ST].qk[kk], b, acc[nt], 0, 0, 0);
        }
      }
      const int rbase = tc * 64 + 16 * mt + 4 * lq;
#pragma unroll
      for (int nt = 0; nt < 2; ++nt)
#pragma unroll
        for (int jj = 0; jj < 4; ++jj) O[(size_t)(rbase + jj) * 1024 + h * 128 + sl * 32 + 16 * nt + lr] = f2bf(acc[nt][jj]);
    }
    {
#pragma unroll
      for (int nt = 0; nt < 2; ++nt)
#pragma unroll
        for (int jj = 0; jj < 4; ++jj) s[nt][jj] *= ring[ST].dl;
#pragma unroll
      for (int kk = 0; kk < 2; ++kk) {
#pragma unroll
        for (int nt = 0; nt < 2; ++nt) {
          bf16x8 b = ld8(vsT + (16 * nt + lr) * 72 + kk * 32 + lq * 8);
          s[nt] = __builtin_amdgcn_mfma_f32_16x16x32_bf16(ring[ST].kt[kk], b, s[nt], 0, 0, 0);
        }
      }
#pragma unroll
      for (int nt = 0; nt < 2; ++nt) {
        uint2 o;
        o.x = pack2(s[nt][0], s[nt][1]);
        o.y = pack2(s[nt][2], s[nt][3]);
        *(uint2*)(sT + (16 * nt + lr) * 136 + 16 * w + 4 * lq) = o;
      }
    }
    lds_barrier();
  };
  for (int step0 = 0; step0 < nch; step0 += 4) {
#define SEQ_SUB(K)                                                                 \
    {                                                                              \
      const int step = step0 + K;                                                  \
      const int c = d ? nch - 1 - step : step;                                     \
      const int nstep = step + 3 < nch ? step + 3 : nch - 1;                       \
      load_a(nstep, ring[(K + 3) & 3]);                                            \
      do_step(step, tc0 + c, nstep, std::integral_constant<int, K>{});             \
    }
    SEQ_SUB(0) SEQ_SUB(1) SEQ_SUB(2) SEQ_SUB(3)
#undef SEQ_SUB
  }
  if (seq >= 0) {
    const int b = g * 4 + seq;
    float* dst = p.out + (d ? OUT_SAB : OUT_SAF) + ((size_t)(b * 8 + h) * 128) * 128;
#pragma unroll
    for (int nt = 0; nt < 2; ++nt)
#pragma unroll
      for (int jj = 0; jj < 4; ++jj) dst[(size_t)(16 * w + 4 * lq + jj) * 128 + sl * 32 + 16 * nt + lr] = s[nt][jj];
  }
}

__device__ __forceinline__ int lru_row(int sc, int jj) {
  if (sc < 16) {
    int j = (sc & 3) * 64 + jj;
    if (j < 0 || j >= 256) return -1;
    return (sc >> 2) * 256 + j;
  } else {
    int j = (sc - 16) * 64 + jj;
    if (j < 0 || j >= 4096) return -1;
    return 1024 + (j & 63) * 64 + (j >> 6);
  }
}

__device__ void lru_item(const Params& p, int g, int item, int pass, long long& tacc) {
  PT0()
  const int t = tid_l(), lane = t & 63, w = t >> 6;
  const int sc = item >> 3, blk = item & 7;
  const int lr = lane & 15, lq = lane >> 4;
  char* L = (char*)shm;
  float* xcf = (float*)L;
  float* Aa = (float*)(L + 32768);
  float* Bb = (float*)(L + 65536);
  float* HF = (float*)(L + 98304);
  us* xcb = (us*)(L + 98304);
  float* carry = (float*)(L + 131072);
  float* stage = (float*)(L + 32768);
  const us* XB = (const us*)(p.ws + ((g & 1) ? WS_XB2 : WS_XB));
  float* AGG = (float*)(p.ws + WS_AGG);
  const int cidx = sc < 16 ? (sc & 3) : sc - 16;
  const int nch = sc < 16 ? 4 : 64;
  const int sc0 = sc < 16 ? (sc & ~3) : 16;

  bf16x8 wfr[4][4];
  {
    const us* WL = (const us*)(p.ws + WS_WL) + (size_t)blk * 512 * 128;
#pragma unroll
    for (int kk = 0; kk < 4; ++kk)
#pragma unroll
      for (int ty = 0; ty < 4; ++ty) wfr[kk][ty] = ld8(WL + (size_t)(ty * 128 + 16 * w + lr) * 128 + kk * 32 + lq * 8);
  }
  float* cwl = (float*)(L + 139264);
  float4 cwv = make_float4(0.f, 0.f, 0.f, 0.f);
  if (t < 160) {
    const int rw = t >> 5, c4 = (t & 31) * 4;
    const float* srcw = rw < 4 ? IN(19) + rw * 1024 + blk * 128 + c4 : IN(20) + blk * 128 + c4;
    cwv = *(const float4*)srcw;
  } else if (t < 352) {
    const int q = t - 160, rw = q >> 5, c4 = (q & 31) * 4;
    const int pi = rw == 0 ? 22 : rw == 1 ? 24 : rw == 2 ? 25 : rw == 3 ? 27 : rw == 4 ? 29 : 30;
    cwv = *(const float4*)(IN(pi) + blk * 128 + c4);
  }
  lds_barrier();
  if (t < 352) *(float4*)(cwl + t * 4) = cwv;
  if (pass == 1) {
    const int nf = cidx, nb = nch - 1 - cidx;
    for (int idx = t; idx < (nf + nb) * 64; idx += 512) {
      int e = idx >> 6, rem = idx & 63, ab = rem >> 5, c4 = (rem & 31) * 4;
      int cp, dir;
      if (e < nf) { cp = e; dir = 0; } else { cp = nch - 1 - (e - nf); dir = 1; }
      *(float4*)(stage + e * 256 + ab * 128 + c4) =
          *(const float4*)(AGG + ((size_t)((sc0 + cp) * 2 + dir) * 2 + ab) * 1024 + blk * 128 + c4);
    }
    lds_barrier();
    if (t < 256) {
      const int dir = t >> 7, ch = t & 127;
      float hh = 0.f;
      if (sc >= 16) hh = IN(dir ? 5 : 4)[(size_t)g * 1024 + blk * 128 + ch];
      const int e0 = dir ? nf : 0, ne = dir ? nb : nf;
      for (int e = 0; e < ne; ++e) hh = stage[(e0 + e) * 256 + ch] * hh + stage[(e0 + e) * 256 + 128 + ch];
      carry[dir * 128 + ch] = hh;
    }
    lds_barrier();
  }
  PTICK(17)
  lds_barrier();
  {
    const int pp = t >> 3, cg8 = t & 7;
    const int chg = blk * 128 + cg8 * 16;
    float y[16];
#pragma unroll
    for (int c = 0; c < 16; ++c) y[c] = cwl[4 * 128 + cg8 * 16 + c];
#pragma unroll
    for (int tap = 0; tap < 4; ++tap) {
      const int row = lru_row(sc, pp - 2 + tap);
      if (row >= 0) {
        const uint4* src = (const uint4*)(XB + (size_t)row * 1024 + chg);
        uint4 a = src[0], b = src[1];
        unsigned wds[8] = {a.x, a.y, a.z, a.w, b.x, b.y, b.z, b.w};
        const float* wt = cwl + tap * 128 + cg8 * 16;
#pragma unroll
        for (int c = 0; c < 8; ++c) {
          y[2 * c] += wt[2 * c] * __uint_as_float(wds[c] << 16);
          y[2 * c + 1] += wt[2 * c + 1] * __uint_as_float(wds[c] & 0xffff0000u);
        }
      }
    }
#pragma unroll
    for (int c = 0; c < 16; ++c) xcf[pp * 128 + cg8 * 16 + c] = y[c];
    uint4 o0, o1;
    o0.x = pack2(y[0], y[1]); o0.y = pack2(y[2], y[3]); o0.z = pack2(y[4], y[5]); o0.w = pack2(y[6], y[7]);
    o1.x = pack2(y[8], y[9]); o1.y = pack2(y[10], y[11]); o1.z = pack2(y[12], y[13]); o1.w = pack2(y[14], y[15]);
    *(uint4*)(xcb + pp * 136 + cg8 * 16) = o0;
    *(uint4*)(xcb + pp * 136 + cg8 * 16 + 8) = o1;
  }
  lds_barrier();
  PTICK(18)
  f32x4 acc[4][4];
  {
#pragma unroll
    for (int ty = 0; ty < 4; ++ty)
#pragma unroll
      for (int m = 0; m < 4; ++m) acc[ty][m] = f32x4{0.f, 0.f, 0.f, 0.f};
#pragma unroll
    for (int kk = 0; kk < 4; ++kk) {
      bf16x8 a[4];
#pragma unroll
      for (int m = 0; m < 4; ++m) a[m] = ld8(xcb + (16 * m + lr) * 136 + kk * 32 + lq * 8);
#pragma unroll
      for (int ty = 0; ty < 4; ++ty)
#pragma unroll
        for (int m = 0; m < 4; ++m) acc[ty][m] = __builtin_amdgcn_mfma_f32_16x16x32_bf16(a[m], wfr[kk][ty], acc[ty][m], 0, 0, 0);
    }
  }
  lds_barrier();
  PTICK(19)
  const int chl = 16 * w + lr, chg1 = blk * 128 + chl;
#pragma unroll
  for (int dir = 0; dir < 2; ++dir) {
    {
      const float* prl = cwl + (5 + dir * 3) * 128 + chl;
      const float ba = prl[0], bx = prl[128];
      const float spl = softplusf_(-prl[256]);
#pragma unroll
      for (int m = 0; m < 4; ++m)
#pragma unroll
        for (int jj = 0; jj < 4; ++jj) {
          const int pos = 16 * m + 4 * lq + jj;
          float r = sigmoidf_(acc[dir * 2][m][jj] + ba);
          float ig = sigmoidf_(acc[dir * 2 + 1][m][jj] + bx);
          float la = -8.f * r * spl;
          float a = __expf(la);
          float bb = __builtin_amdgcn_sqrtf(fmaxf(1.f - a * a, 0.f)) * ig * xcf[pos * 128 + chl];
          Aa[pos * 128 + chl] = a;
          Bb[pos * 128 + chl] = bb;
        }
    }
    lds_barrier();
    PTICK(20)
    {
      float* SA = carry + 256;
      float* SB = carry + 768;
      const int seg = t >> 7, ch = t & 127, chg = blk * 128 + ch;
      const int pbase = dir ? 63 - 16 * seg : 16 * seg;
      const int pstep = dir ? -128 : 128;
      float* ap_ = Aa + pbase * 128 + ch;
      float* bp_ = Bb + pbase * 128 + ch;
      float av[16], bv[16];
#pragma unroll
      for (int i = 0; i < 16; ++i) { av[i] = ap_[i * pstep]; bv[i] = bp_[i * pstep]; }
      float prod = 1.f, hh = 0.f;
#pragma unroll
      for (int i = 0; i < 16; ++i) { hh = av[i] * hh + bv[i]; prod *= av[i]; av[i] = prod; bv[i] = hh; }
      SA[seg * 128 + ch] = prod;
      SB[seg * 128 + ch] = hh;
      lds_barrier();
      if (pass == 0) {
        if (seg == 0) {
          float pa = 1.f, hb = 0.f;
#pragma unroll
          for (int s2 = 0; s2 < 4; ++s2) { const float a2 = SA[s2 * 128 + ch]; hb = a2 * hb + SB[s2 * 128 + ch]; pa *= a2; }
          AGG[((size_t)(sc * 2 + dir) * 2 + 0) * 1024 + chg] = pa;
          AGG[((size_t)(sc * 2 + dir) * 2 + 1) * 1024 + chg] = hb;
        }
      } else {
        float cin = carry[dir * 128 + ch];
        for (int s2 = 0; s2 < seg; ++s2) cin = SA[s2 * 128 + ch] * cin + SB[s2 * 128 + ch];
        float* hp_ = HF + pbase * 128 + ch;
        float hlast = 0.f;
#pragma unroll
        for (int i = 0; i < 16; ++i) {
          const float hv = bv[i] + av[i] * cin;
          if (dir == 0) hp_[i * pstep] = hv; else hp_[i * pstep] += hv;
          hlast = hv;
        }
        if (seg == 3 && sc < 16) {
          if (dir == 0 && cidx == 3) p.out[OUT_SBF + (size_t)(g * 4 + (sc >> 2)) * 1024 + chg] = hlast;
          if (dir == 1 && cidx == 0) p.out[OUT_SBB + (size_t)(g * 4 + (sc >> 2)) * 1024 + chg] = hlast;
        }
      }
    }
    lds_barrier();
  }
  PTICK(21)
  if (pass == 1) {
    us* OCAT = (us*)(p.ws + WS_OCAT);
    const int pp = t >> 3, cg8 = t & 7;
    const int R = grow(g, lru_row(sc, pp));
    const float* hs = HF + pp * 128 + cg8 * 16;
    uint4 o0, o1;
    o0.x = pack2(hs[0], hs[1]); o0.y = pack2(hs[2], hs[3]); o0.z = pack2(hs[4], hs[5]); o0.w = pack2(hs[6], hs[7]);
    o1.x = pack2(hs[8], hs[9]); o1.y = pack2(hs[10], hs[11]); o1.z = pack2(hs[12], hs[13]); o1.w = pack2(hs[14], hs[15]);
    us* dst = OCAT + (size_t)R * 2048 + 1024 + blk * 128 + cg8 * 16;
    *(uint4*)dst = o0;
    *(uint4*)(dst + 8) = o1;
  }
  lds_barrier();
}

__device__ void phase_finalize(const Params& p, int g, const us* OF, const us* OB) {
  const int t_ = tid_l();
  const int lane = t_ & 63, wv = t_ >> 6;
  const float* ow = IN(18);
  us* OCAT = (us*)(p.ws + WS_OCAT);
  for (int r = blockIdx.x * 8 + wv; r < GR; r += gridDim.x * 8) {
    const int R = grow(g, r);
    const int e0 = lane * 16;
    float o[16];
    float ss = 0.f;
    {
      const uint4* pa = (const uint4*)(OF + (size_t)r * 1024 + e0);
      const uint4* pb = (const uint4*)(OB + (size_t)r * 1024 + e0);
      const uint4 a0 = pa[0], a1 = pa[1], b0 = pb[0], b1 = pb[1];
      const unsigned wa[8] = {a0.x, a0.y, a0.z, a0.w, a1.x, a1.y, a1.z, a1.w};
      const unsigned wb[8] = {b0.x, b0.y, b0.z, b0.w, b1.x, b1.y, b1.z, b1.w};
#pragma unroll
      for (int i = 0; i < 8; ++i) {
        o[2 * i] = __uint_as_float(wa[i] << 16) + __uint_as_float(wb[i] << 16);
        o[2 * i + 1] = __uint_as_float(wa[i] & 0xffff0000u) + __uint_as_float(wb[i] & 0xffff0000u);
      }
    }
#pragma unroll
    for (int i = 0; i < 16; ++i) ss += o[i] * o[i];
    ss += shfl_lane(ss, lane ^ 1);
    ss += shfl_lane(ss, lane ^ 2);
    ss += shfl_lane(ss, lane ^ 4);
    const float rstd = rsqrtf(ss * (1.f / 128.f) + 1e-6f);
    const int wo = (lane & 7) * 16;
    uint4 o0, o1;
    float y[16];
#pragma unroll
    for (int i = 0; i < 16; ++i) y[i] = o[i] * rstd * ow[wo + i];
    o0.x = pack2(y[0], y[1]); o0.y = pack2(y[2], y[3]); o0.z = pack2(y[4], y[5]); o0.w = pack2(y[6], y[7]);
    o1.x = pack2(y[8], y[9]); o1.y = pack2(y[10], y[11]); o1.z = pack2(y[12], y[13]); o1.w = pack2(y[14], y[15]);
    us* dst = OCAT + (size_t)R * 2048 + e0;
    *(uint4*)dst = o0;
    *(uint4*)(dst + 8) = o1;
  }
}

#define XB_TMO      128
#define XB_XCNT(j)  (256  + 64 * (j))
#define XB_XSUB(j)  (1280 + 64 * (j))
#define XB_XGEN(j)  (2304 + 64 * (j))
#define XB_TOP      3328
#define XB_TOPGEN   3392
#define XCD_BAR_WORDS 3456
#define XB_SPIN_CAP (1u << 18)
#define LAS __attribute__((address_space(3)))

__device__ __forceinline__ unsigned xb_ld(unsigned* p)              { return __hip_atomic_load(p, __ATOMIC_RELAXED, __HIP_MEMORY_SCOPE_AGENT); }
__device__ __forceinline__ unsigned xb_add(unsigned* p, unsigned v) { return __hip_atomic_fetch_add(p, v, __ATOMIC_RELAXED, __HIP_MEMORY_SCOPE_AGENT); }
__device__ __forceinline__ unsigned xb_xcc_id() { return (unsigned)__builtin_amdgcn_s_getreg((3 << 11) | 20) & 0xFu; }
#define XB_SPIN(cond, bar) do { unsigned _sp = 0; while (cond) { __builtin_amdgcn_s_sleep(1); \
    if ((++_sp & 255u) == 0u) { if (xb_ld(&(bar)[XB_TMO])) break; if (_sp > XB_SPIN_CAP) { atomicAdd(&(bar)[XB_TMO], 1u); break; } } } } while (0)

struct XcdBarrier {
    unsigned* bar; unsigned x;
    volatile LAS unsigned* st;
};

__device__ __forceinline__ XcdBarrier xcd_barrier_post(unsigned* bar, volatile LAS unsigned* st) {
    XcdBarrier b; b.bar = bar; b.x = xb_xcc_id(); b.st = st;
    if (threadIdx.x == 0) (void)xb_add(&bar[XB_XCNT(b.x)], 1u);
    return b;
}
__device__ __forceinline__ void xcd_barrier_complete(unsigned* bar, unsigned x, unsigned& nloc, unsigned& nx) {
    const unsigned G = gridDim.x * gridDim.y * gridDim.z;
    unsigned sum, cnt, mine, sp = 0u;
    for (;;) {
        sum = 0u; cnt = 0u; mine = 0u;
#pragma unroll
        for (unsigned j = 0; j < 16; ++j) { const unsigned c = xb_ld(&bar[XB_XCNT(j)]); sum += c; cnt += (c > 0u) ? 1u : 0u; mine = (j == x) ? c : mine; }
        if (sum == G) break;
        __builtin_amdgcn_s_sleep(1);
        if ((++sp & 255u) == 0u) { if (xb_ld(&bar[XB_TMO])) break; if (sp > XB_SPIN_CAP) { atomicAdd(&bar[XB_TMO], 1u); break; } }
    }
    nloc = mine > 0u ? mine : 1u; nx = cnt > 0u ? cnt : 1u;
}

__device__ __forceinline__ void xcd_barrier(const XcdBarrier& b) {
    asm volatile("s_waitcnt vmcnt(0)" ::: "memory");
    __syncthreads();
    if (threadIdx.x == 0) {
        unsigned* bar = b.bar;
        __builtin_amdgcn_s_waitcnt(0);
        unsigned nloc = b.st[0], nx = b.st[1];
        if (nloc == 0u) { xcd_barrier_complete(bar, b.x, nloc, nx); b.st[0] = nloc; b.st[1] = nx; }
        const unsigned old = xb_add(&bar[XB_XSUB(b.x)], 1u);
        const unsigned gen = old / nloc;
        if (old + 1u == (gen + 1u) * nloc) {
            __builtin_amdgcn_fence(__ATOMIC_RELEASE, "agent");
            asm volatile("s_waitcnt vmcnt(0)" ::: "memory");
            const unsigned og = xb_add(&bar[XB_TOP], 1u);
            const unsigned tg = og / nx;
            if (og + 1u == (tg + 1u) * nx) xb_add(&bar[XB_TOPGEN], 1u);
            else XB_SPIN(xb_ld(&bar[XB_TOPGEN]) == tg, bar);
            __builtin_amdgcn_fence(__ATOMIC_ACQUIRE, "agent");
            xb_add(&bar[XB_XGEN(b.x)], 1u);
            asm volatile("s_waitcnt vmcnt(0)" ::: "memory");
        } else {
            XB_SPIN(xb_ld(&bar[XB_XGEN(b.x)]) == gen, bar);
            __builtin_amdgcn_fence(__ATOMIC_ACQUIRE, "agent");
            asm volatile("s_waitcnt vmcnt(0)" ::: "memory");
        }
    }
    __syncthreads();
}


__global__ void __launch_bounds__(512) fwd_megakernel(Params p) {
  cg::grid_group grid = cg::this_grid();
#define XB_WORDS ((volatile LAS unsigned*)((LAS char*)shm + (LDS_BYTES - 16)))
  if (threadIdx.x == 0) { XB_WORDS[0] = 0u; XB_WORDS[1] = 0u; }
  __syncthreads();
  (void)xcd_barrier_post((unsigned*)(p.ws + WS_BAR), XB_WORDS);
#define GRID_BAR()                                                                                 \
  {                                                                                                \
    XcdBarrier xb_;                                                                                \
    xb_.bar = (unsigned*)(p.ws + WS_BAR + zopaque());                                              \
    xb_.x = xb_xcc_id();                                                                           \
    xb_.st = XB_WORDS;                                                                             \
    xcd_barrier(xb_);                                                                              \
  }
#define H_PTR ((bf16*)p.out)
#define OF_PTR ((us*)(p.ws + WS_OF))
#define OB_PTR ((us*)(p.ws + WS_OB))

#ifndef PROBE_MASK
#define PROBE_MASK 0
#endif
  long long tacc = 0;
#if PROBE_MASK
  long long tprev = wall_clock64();
#define TICK(PH)                                              \
  {                                                           \
    long long tn_ = wall_clock64();                           \
    if ((PROBE_MASK >> (PH)) & 1) tacc += tn_ - tprev;        \
    tprev = tn_;                                              \
  }
#define WCLK() wall_clock64()
#else
#define TICK(PH)
#define WCLK() 0ll
#endif
  phase_mod(p);
  phase_weights(p);
  GRID_BAR()
  if (p.ws == nullptr) grid.sync();
  TICK(0)
  phase_h(p, H_PTR);
  GRID_BAR()
  TICK(1)
  for (int ph_ = 0; ph_ <= NG + 1; ++ph_) {
    const int ph = __builtin_amdgcn_readfirstlane(ph_);
    {
      const int b = blockIdx.x;
      const bool seqph = (ph > 0) && (ph <= NG);
      const bool lat = seqph && (gridDim.x >= 128) && (b < 64);
      const int nG = (ph < NG) ? 340 : 0;
      const int nB = (ph == NG) ? 36 * 16 : (ph == NG + 1 ? 44 * 16 : 0);
      const int nL = seqph ? 640 : 0;
      const int nC = seqph ? ((gridDim.x >= 128) ? 256 : 320) : 0;
      const int c0 = (gridDim.x >= 128) ? 64 : 0;
      unsigned* qctr = (unsigned*)(p.ws + WS_BAR) + 3500 + ph;
      volatile LAS unsigned* qword = (volatile LAS unsigned*)((LAS char*)shm + (LDS_BYTES - 32));
      bool first = lat;
      for (;;) {
        int kind, arg;
        if (first) {
          const int xcd_ = b & 7, k_ = b >> 3;
          kind = 2; arg = (xcd_ * 2 + (k_ >> 2)) * 4 + (k_ & 3); first = false;
        }
        else {
          lds_barrier();
          if (threadIdx.x == 0) qword[0] = __hip_atomic_fetch_add(qctr, 1u, __ATOMIC_RELAXED, __HIP_MEMORY_SCOPE_AGENT);
          lds_barrier();
          const int idx = (int)qword[0];
          if (idx >= nG + nB + nL + nC) break;
          if (idx < nG) { kind = 0; arg = idx; }
          else if (idx < nG + nB) { kind = 3; arg = idx - nG; }
          else if (idx < nG + nB + nL) { kind = 1; arg = idx - nG - nB; }
          else { kind = 2; arg = c0 + idx - nG - nB - nL; }
        }
        if (kind == 0) phase_gemm1a(p, H_PTR, ph, arg, 1 << 20);
        else if (kind == 3) phase_gemm1b(p, H_PTR, arg, 1 << 20, ph == NG ? 0 : 1);
        else if (kind == 1) lru_item(p, ph - 1, arg, 1, tacc);
        else {
          long long ta_ = WCLK();
          gdn_seq_item(p, ph - 1, arg, OF_PTR, OB_PTR);
          long long tb_ = WCLK();
          if (((PROBE_MASK >> 12) & 1) && arg < 64) tacc += tb_ - ta_;
        }
      }
    }
    GRID_BAR()
    TICK(4)
    if (ph <= NG) {
      const int g = ph;
      if (g > 0) phase_finalize(p, g - 1, OF_PTR, OB_PTR);
      if (ph < NG) {
        for (int it = blockIdx.x; it < 1280; it += gridDim.x) {
          long long ta_ = WCLK();
          if (it < 640) gdn_prep_item(p, it, tacc);
          else lru_item(p, g, it - 640, 0, tacc);
          long long tb_ = WCLK();
          if ((PROBE_MASK >> (it < 640 ? 10 : 11)) & 1) tacc += tb_ - ta_;
        }
      }
      GRID_BAR()
      TICK(3)
    }
  }
  {
    unsigned* qctr = (unsigned*)(p.ws + WS_BAR) + 3510;
    unsigned* rbcnt = (unsigned*)(p.ws + WS_BAR) + 3520;
    volatile LAS unsigned* qword = (volatile LAS unsigned*)((LAS char*)shm + (LDS_BYTES - 32));
    unsigned* tflag = (unsigned*)(p.ws + WS_BAR) + 3600;
    for (;;) {
      lds_barrier();
      if (threadIdx.x == 0) qword[0] = __hip_atomic_fetch_add(qctr, 1u, __ATOMIC_RELAXED, __HIP_MEMORY_SCOPE_AGENT);
      lds_barrier();
      const int idx = (int)qword[0];
      if (idx >= 960) break;
      if (idx < 640) {
        const int half = idx >= 320 ? 1 : 0;
        const int tile = idx - half * 320;
        if (half) {
          if (threadIdx.x == 0) {
            while (__hip_atomic_load(tflag + tile, __ATOMIC_RELAXED, __HIP_MEMORY_SCOPE_AGENT) < 1u) __builtin_amdgcn_s_sleep(2);
            __builtin_amdgcn_fence(__ATOMIC_ACQUIRE, "agent");
            asm volatile("s_waitcnt vmcnt(0)" ::: "memory");
          }
          lds_barrier();
        }
        phase_gemm3(p, tile, half);
        asm volatile("s_waitcnt vmcnt(0)" ::: "memory");
        lds_barrier();
        if (threadIdx.x == 0)
          __hip_atomic_fetch_add(half ? rbcnt + (tile >> 2) : tflag + tile, 1u, __ATOMIC_RELAXED, __HIP_MEMORY_SCOPE_AGENT);
      } else {
        const int j = idx - 640;
        if (threadIdx.x == 0) {
          while (__hip_atomic_load(rbcnt + (j >> 2), __ATOMIC_RELAXED, __HIP_MEMORY_SCOPE_AGENT) < 4u) __builtin_amdgcn_s_sleep(2);
          __builtin_amdgcn_fence(__ATOMIC_ACQUIRE, "agent");
          asm volatile("s_waitcnt vmcnt(0)" ::: "memory");
        }
        lds_barrier();
        phase_gemm4(p, j, 1 << 20);
      }
    }
  }
  GRID_BAR()
  TICK(8)
#ifdef EXTRA_SYNCS
  for (int i = 0; i < EXTRA_SYNCS; ++i) GRID_BAR()
#endif
  phase_final(p);
  TICK(9)
#if PROBE_MASK
  if (blockIdx.x == 0) {
    long long s0 = wall_clock64();
    while (wall_clock64() - s0 < tacc) {}
  }
#endif
}

extern "C" void kernel_launch(void* const* d_in, const int* in_sizes, int n_in, void* d_out, int out_size, void* d_ws,
                              size_t ws_size, hipStream_t stream) {
  static int grid_blocks = 0;
  if (grid_blocks == 0) {
    int dev = 0, cus = 0, per_cu = 0;
    hipGetDevice(&dev);
    hipDeviceGetAttribute(&cus, hipDeviceAttributeMultiprocessorCount, dev);
    if (hipFuncSetAttribute((const void*)fwd_megakernel, hipFuncAttributeMaxDynamicSharedMemorySize, LDS_BYTES) != hipSuccess)
      fprintf(stderr, "hipFuncSetAttribute failed\n");
    hipOccupancyMaxActiveBlocksPerMultiprocessor(&per_cu, (const void*)fwd_megakernel, 512, LDS_BYTES);
    if (per_cu < 1) { fprintf(stderr, "occupancy query says %d blocks/CU\n", per_cu); per_cu = 1; }
    if (per_cu > 1) per_cu = 1;
    grid_blocks = cus * per_cu;
    if (ws_size < WS_END2) fprintf(stderr, "workspace too small: %zu < %zu\n", ws_size, (size_t)WS_END);
  }
  Params p{};
  for (int i = 0; i < 37; ++i) p.in[i] = (const float*)d_in[i];
  p.out = (float*)d_out;
  p.ws = (char*)d_ws;
  if (hipMemsetAsync((char*)d_ws + WS_BAR, 0, 16384, stream) != hipSuccess) fprintf(stderr, "memset of barrier words failed\n");
  void* args[] = {&p};
  hipError_t e = hipLaunchCooperativeKernel((const void*)fwd_megakernel, dim3(grid_blocks), dim3(512), args, LDS_BYTES, stream);
  if (e != hipSuccess) fprintf(stderr, "cooperative launch failed: %s (grid %d)\n", hipGetErrorString(e), grid_blocks);
}
```

```cpp
#include <hip/hip_runtime.h>
#include <hip/hip_bf16.h>
#include <hip/hip_cooperative_groups.h>
#include <cstdio>
#include <cstdint>
#include <type_traits>
namespace cg = cooperative_groups;

using bf16 = __hip_bfloat16;
using bf16x8 = __attribute__((ext_vector_type(8))) short;
using f32x4 = __attribute__((ext_vector_type(4))) float;
typedef unsigned short us;

constexpr int DM = 1024;
constexpr int NTOK = 20480;
constexpr int NG = 4;
constexpr int GR = 5120;
constexpr int NA = 4352;
constexpr int NB1 = 4096;
constexpr int OUT_SAF = 20971520, OUT_SAB = 23068672, OUT_SBF = 25165824, OUT_SBB = 25182208;

constexpr size_t WS_WA = 0;
constexpr size_t WS_WB = WS_WA + (size_t)NA * 1024 * 2;
constexpr size_t WS_WPA = WS_WB + (size_t)NB1 * 1024 * 2;
constexpr size_t WS_WPB = WS_WPA + 4194304;
constexpr size_t WS_WOUT = WS_WPB + 4194304;
constexpr size_t WS_WL = WS_WOUT + 4194304;
constexpr size_t WS_MOD = WS_WL + 1048576;
constexpr size_t WS_OCAT = WS_MOD + 65536;
constexpr size_t WS_BIG = WS_OCAT + (size_t)NTOK * 2048 * 2;
constexpr size_t WS_QKV = WS_BIG;
constexpr size_t WS_XB = WS_QKV + (size_t)GR * 3072 * 2;
constexpr size_t WS_GC = WS_XB + (size_t)GR * 1024 * 2;
constexpr size_t WS_AGG = WS_GC + (size_t)GR * 32 * 4;
constexpr size_t WS_Q = WS_AGG + (size_t)80 * 4 * 1024 * 4;
constexpr size_t WS_KT = WS_Q + (size_t)640 * 8192 * 2;
constexpr size_t WS_WN = WS_KT + (size_t)640 * 8192 * 2;
constexpr size_t WS_U = WS_WN + (size_t)1280 * 8192 * 2;
constexpr size_t WS_QKM = WS_U + (size_t)1280 * 8192 * 2;
constexpr size_t WS_EG = WS_QKM + (size_t)1280 * 4096 * 2;
constexpr size_t WS_ES = WS_EG + (size_t)1280 * 64 * 4;
constexpr size_t WS_DL = WS_ES + (size_t)1280 * 64 * 4;
constexpr size_t WS_GEND = WS_DL + 8192;
constexpr size_t WS_GATE = WS_BIG;
constexpr size_t WS_END = WS_GATE + (size_t)NTOK * 2048 * 2;
static_assert(WS_GEND <= 268435456ull, "group region too large");
constexpr size_t WS_OF = (WS_END > WS_GEND ? WS_END : WS_GEND);
constexpr size_t WS_OB = WS_OF + (size_t)GR * 1024 * 2;
constexpr size_t WS_XB2 = WS_OB + (size_t)GR * 1024 * 2;
constexpr size_t WS_BAR = WS_XB2 + (size_t)GR * 1024 * 2;
constexpr size_t WS_END2 = WS_BAR + 16384;
static_assert(WS_END2 <= 268435456ull, "workspace too large");

#ifndef PROBE_MASK
#define PROBE_MASK 0
#endif
constexpr int LDS_BYTES = 147456;

struct Params {
  const float* in[37];
  float* out;
  char* ws;
};

extern __shared__ __attribute__((aligned(16))) bf16 shm[];

typedef __bf16 hwbf2 __attribute__((ext_vector_type(2)));
typedef float hwf2 __attribute__((ext_vector_type(2)));
__device__ __forceinline__ us f2bf(float f) { return __builtin_bit_cast(us, (__bf16)f); }
__device__ __forceinline__ float bf2f(us b) { return __uint_as_float(((unsigned)b) << 16); }
__device__ __forceinline__ float frcp_(float x) { return __builtin_amdgcn_rcpf(x); }
__device__ __forceinline__ float sigmoidf_(float x) { return frcp_(1.f + __expf(-x)); }
__device__ __forceinline__ float siluf_(float x) { return x * frcp_(1.f + __expf(-x)); }
__device__ __forceinline__ float softplusf_(float x) { return x > 20.f ? x : log1pf(__expf(x)); }
__device__ __forceinline__ unsigned pack2(float a, float b) {
  hwf2 v = {a, b};
  return __builtin_bit_cast(unsigned, __builtin_convertvector(v, hwbf2));
}

__device__ __forceinline__ void lds_barrier() {
  asm volatile("s_waitcnt lgkmcnt(0)" ::: "memory");
  __builtin_amdgcn_s_barrier();
  asm volatile("" ::: "memory");
}

__device__ __forceinline__ int zopaque() {
  int z;
  asm volatile("s_mov_b32 %0, 0" : "=s"(z));
  return z;
}
#define IN(K) (p.in[(K) + zopaque()])

__device__ __forceinline__ int tid_l() {
  int t = threadIdx.x;
  asm volatile("" : "+v"(t));
  return t;
}

__device__ __forceinline__ float shfl_lane(float v, int src_lane) {
  return __int_as_float(__builtin_amdgcn_ds_bpermute(src_lane << 2, __float_as_int(v)));
}

__device__ __forceinline__ int grow(int g, int r) {
  return r < 1024 ? g * 1024 + r : 4096 + g * 4096 + (r - 1024);
}
__device__ __forceinline__ const float* xrow(const Params& p, int R) {
  return R < 4096 ? IN(0) + (size_t)R * 1024 : IN(1) + (size_t)(R - 4096) * 1024;
}
__device__ __forceinline__ int modidx(int R) { return R < 4096 ? 0 : 1 + ((R - 4096) >> 12); }

constexpr int BK = 64, HALF = 128, HT = HALF * BK;
__device__ __forceinline__ int lds_byte(int r, int c) {
  int st = (r >> 4) * 2 + (c >> 5), rr = r & 15, cc = c & 31, ob = rr * 64 + cc * 2;
  return st * 1024 + (ob ^ (((ob >> 9) & 1) << 5));
}
__device__ __forceinline__ void stage_rc(int b, int& R, int& C) {
  int st = b / 1024, sb = b % 1024, swz = sb ^ (((sb >> 9) & 1) << 5);
  R = (st >> 1) * 16 + swz / 64;
  C = (st & 1) * 32 + (swz % 64) / 2;
}

__device__ __forceinline__ void gemm_tile(const bf16* __restrict__ A, int lda, const bf16* __restrict__ Bt, int ldb, int K,
                                          f32x4 (&acc)[2][2][4][2]) {
#define SA(b, h) (shm + ((b)*2 + (h)) * HT)
#define SB(b, h) (shm + (4 + (b)*2 + (h)) * HT)
#define STAGE(P, BASE, LD, br, kt)                                                                       \
  do {                                                                                                   \
    const bf16* _gb = (BASE) + ((long)(br) * (LD) + (long)(kt)*BK);                                      \
    const int _o0 = ((LD) == lda) ? oa0 : ob0, _o1 = ((LD) == lda) ? oa1 : ob1;                          \
    __builtin_amdgcn_global_load_lds((const unsigned*)(_gb + _o0), (unsigned*)((char*)(P) + lb0), 16, 0, 0); \
    __builtin_amdgcn_global_load_lds((const unsigned*)(_gb + _o1), (unsigned*)((char*)(P) + lb0 + 8192), 16, 0, 0); \
  } while (0)
#define LDA(dst, b, h)                                                                                   \
  _Pragma("unroll") for (int m = 0; m < 4; ++m)                                                          \
    _Pragma("unroll") for (int k = 0; k < 2; ++k)                                                        \
  dst[m][k] = *reinterpret_cast<const bf16x8*>((char*)shm + (((b)*2 + (h)) * 16384 + m * 2048 + k * 1024) + baseA)
#define LDB(dst, b, h)                                                                                   \
  _Pragma("unroll") for (int n = 0; n < 2; ++n)                                                          \
    _Pragma("unroll") for (int k = 0; k < 2; ++k)                                                        \
  dst[n][k] = *reinterpret_cast<const bf16x8*>((char*)shm + ((4 + (b)*2 + (h)) * 16384 + n * 2048 + k * 1024) + baseB)
#define MMA(ai, bj, At, Bt_)                                                                             \
  do {                                                                                                   \
    __builtin_amdgcn_s_setprio(1);                                                                       \
    _Pragma("unroll") for (int m = 0; m < 4; ++m)                                                        \
      _Pragma("unroll") for (int n = 0; n < 2; ++n)                                                      \
        _Pragma("unroll") for (int k = 0; k < 2; ++k)                                                    \
          acc[ai][bj][m][n] = __builtin_amdgcn_mfma_f32_16x16x32_bf16(At[m][k], Bt_[n][k], acc[ai][bj][m][n], 0, 0, 0); \
    __builtin_amdgcn_s_setprio(0);                                                                       \
  } while (0)
#define WAIT_V(n) asm volatile("s_waitcnt vmcnt(" #n ")" ::: "memory")
#define WAIT_L(n) asm volatile("s_waitcnt lgkmcnt(" #n ")" ::: "memory")
#define BAR __builtin_amdgcn_s_barrier()
#define SCHED __builtin_amdgcn_sched_barrier(0)
  const int tid = tid_l();
  const int wid = tid >> 6, lane = tid & 63, wr = wid >> 2, wc = wid & 3, fr = lane & 15, fq = lane >> 4;
  bf16x8 At[4][2], B0[2][2], B1[2][2];
  const int nt = K / BK;
  const int ob_ = fr * 64 + fq * 16;
  const int swz_ = ob_ ^ (((ob_ >> 9) & 1) << 5);
  const int baseA = wr * 8192 + swz_, baseB = wc * 4096 + swz_;
  const int lb0 = tid * 16;
  int r_0, c_0, r_1, c_1;
  stage_rc(lb0, r_0, c_0);
  stage_rc(lb0 + 8192, r_1, c_1);
  const int oa0 = r_0 * lda + c_0, oa1 = r_1 * lda + c_1, ob0 = r_0 * ldb + c_0, ob1 = r_1 * ldb + c_1;
  const int brow = 0, bcol = 0;
  STAGE(SB(0, 0), Bt, ldb, bcol, 0);
  STAGE(SA(0, 0), A, lda, brow, 0);
  STAGE(SB(0, 1), Bt, ldb, bcol + HALF, 0);
  STAGE(SA(0, 1), A, lda, brow + HALF, 0);
  if (wr == 1) BAR;
  WAIT_V(4);
  BAR;
  STAGE(SB(1, 0), Bt, ldb, bcol, 1);
  STAGE(SA(1, 0), A, lda, brow, 1);
  STAGE(SB(1, 1), Bt, ldb, bcol + HALF, 1);
  WAIT_V(6);
  BAR;
  for (int t = 0; t < nt - 2; t += 2) {
    LDB(B0, 0, 0); SCHED; LDA(At, 0, 0); STAGE(SA(1, 1), A, lda, brow + HALF, t + 1);
    WAIT_L(8); BAR; WAIT_L(0); MMA(0, 0, At, B0); BAR; SCHED;
    LDB(B1, 0, 1); STAGE(SB(0, 0), Bt, ldb, bcol, t + 2);
    BAR; WAIT_L(0); MMA(0, 1, At, B1); BAR;
    LDA(At, 0, 1); STAGE(SA(0, 0), A, lda, brow, t + 2);
    BAR; WAIT_L(0); MMA(1, 0, At, B0); BAR; SCHED;
    STAGE(SB(0, 1), Bt, ldb, bcol + HALF, t + 2);
    WAIT_V(6); BAR; MMA(1, 1, At, B1); BAR;
    LDB(B0, 1, 0); SCHED; LDA(At, 1, 0); STAGE(SA(0, 1), A, lda, brow + HALF, t + 2);
    WAIT_L(8); BAR; WAIT_L(0); MMA(0, 0, At, B0); BAR; SCHED;
    LDB(B1, 1, 1); STAGE(SB(1, 0), Bt, ldb, bcol, t + 3);
    BAR; WAIT_L(0); MMA(0, 1, At, B1); BAR;
    LDA(At, 1, 1); STAGE(SA(1, 0), A, lda, brow, t + 3);
    BAR; WAIT_L(0); MMA(1, 0, At, B0); BAR; SCHED;
    STAGE(SB(1, 1), Bt, ldb, bcol + HALF, t + 3);
    WAIT_V(6); BAR; MMA(1, 1, At, B1); BAR;
  }
  {
    LDB(B0, 0, 0); LDA(At, 0, 0); STAGE(SA(1, 1), A, lda, brow + HALF, nt - 1);
    BAR; WAIT_L(0); MMA(0, 0, At, B0); BAR;
    LDB(B1, 0, 1); BAR; WAIT_L(0); MMA(0, 1, At, B1); BAR;
    LDA(At, 0, 1); WAIT_V(4); BAR; WAIT_L(0); MMA(1, 0, At, B0); MMA(1, 1, At, B1); BAR;
  }
  {
    LDB(B0, 1, 0); LDA(At, 1, 0); WAIT_V(2); BAR; WAIT_L(0); MMA(0, 0, At, B0); BAR;
    LDB(B1, 1, 1); WAIT_V(0); BAR; WAIT_L(0); MMA(0, 1, At, B1); BAR;
    LDA(At, 1, 1); BAR; WAIT_L(0); MMA(1, 0, At, B0); MMA(1, 1, At, B1); BAR;
  }
  if (wr == 0) BAR;
}

template <class F>
__device__ __forceinline__ void epilogue(f32x4 (&acc)[2][2][4][2], F f) {
  float* tile = (float*)shm;
  int tid = threadIdx.x;
  asm volatile("" : "+v"(tid));
  const int wid = tid >> 6, lane = tid & 63, wr = wid >> 2, wc = wid & 3, fr = lane & 15, fq = lane >> 4;
#pragma unroll
  for (int ai = 0; ai < 2; ++ai) {
    lds_barrier();
#pragma unroll
    for (int bj = 0; bj < 2; ++bj)
#pragma unroll
      for (int m = 0; m < 4; ++m)
#pragma unroll
        for (int n = 0; n < 2; ++n)
#pragma unroll
          for (int j = 0; j < 4; ++j)
            tile[(wr * 64 + m * 16 + fq * 4 + j) * 260 + bj * 128 + wc * 32 + n * 16 + fr] = acc[ai][bj][m][n][j];
    lds_barrier();
#pragma unroll 4
    for (int it = 0; it < 16; ++it) {
      const int idx = it * 512 + tid;
      const int row = idx >> 6, c4 = (idx & 63) * 4;
      const float4 v = *(const float4*)(tile + row * 260 + c4);
      f(ai * 128 + row, c4, v);
    }
  }
  lds_barrier();
}

__device__ __forceinline__ void zero_acc(f32x4 (&acc)[2][2][4][2]) {
#pragma unroll
  for (int a = 0; a < 2; ++a)
#pragma unroll
    for (int b = 0; b < 2; ++b)
#pragma unroll
      for (int m = 0; m < 4; ++m)
#pragma unroll
        for (int n = 0; n < 2; ++n) acc[a][b][m][n] = f32x4{0.f, 0.f, 0.f, 0.f};
}

__device__ void phase_mod(const Params& p) {
  float* sc = (float*)shm;
  float* part = sc + 5 * 1024;
  const int t = tid_l();
  for (int i = t; i < 5 * 1024; i += 512) {
    int v = i >> 10, k = i & 1023;
    float c = v == 0 ? IN(7)[k] : IN(6)[(v - 1) * 1024 + k];
    sc[i] = siluf_(c);
  }
  lds_barrier();
  const int cc = t & 15, kk = t >> 4;
  for (int cgp = blockIdx.x; cgp < 256; cgp += gridDim.x) {
    const int col = cgp * 12 + cc;
    float a[5] = {0.f, 0.f, 0.f, 0.f, 0.f};
    if (cc < 12) {
      const float* w = IN(9);
      for (int k = kk; k < 1024; k += 32) {
        float wv = w[(size_t)k * 3072 + col];
#pragma unroll
        for (int v = 0; v < 5; ++v) a[v] += sc[v * 1024 + k] * wv;
      }
    }
#pragma unroll
    for (int v = 0; v < 5; ++v) part[(kk * 5 + v) * 16 + cc] = a[v];
    lds_barrier();
    if (t < 80) {
      int v = t >> 4, c2 = t & 15;
      int col2 = cgp * 12 + c2;
      if (c2 < 12) {
        float s = 0.f;
        for (int k2 = 0; k2 < 32; ++k2) s += part[(k2 * 5 + v) * 16 + c2];
        ((float*)(p.ws + WS_MOD))[v * 3072 + col2] = s + IN(10)[col2];
      }
    }
    lds_barrier();
  }
}

__device__ void tr_tile(const float* __restrict__ src, int ld_src, int col0, int nN, bf16* __restrict__ dst, int ld_dst,
                        int kt, int ntile) {
  float* tile = (float*)shm;
  const int t = tid_l();
  const int k0 = kt * 64, n0 = ntile * 64;
  {
    const int n4 = (t & 15) * 4;
    for (int kk = t >> 4; kk < 64; kk += 32) {
      float4 v = make_float4(0.f, 0.f, 0.f, 0.f);
      if (n0 + n4 < nN) v = *reinterpret_cast<const float4*>(src + (size_t)(k0 + kk) * ld_src + col0 + n0 + n4);
      tile[kk * 65 + n4 + 0] = v.x;
      tile[kk * 65 + n4 + 1] = v.y;
      tile[kk * 65 + n4 + 2] = v.z;
      tile[kk * 65 + n4 + 3] = v.w;
    }
  }
  lds_barrier();
  {
    const int n = t >> 3, k8 = (t & 7) * 8;
    if (n0 + n < nN) {
      uint4 o;
      o.x = pack2(tile[(k8 + 0) * 65 + n], tile[(k8 + 1) * 65 + n]);
      o.y = pack2(tile[(k8 + 2) * 65 + n], tile[(k8 + 3) * 65 + n]);
      o.z = pack2(tile[(k8 + 4) * 65 + n], tile[(k8 + 5) * 65 + n]);
      o.w = pack2(tile[(k8 + 6) * 65 + n], tile[(k8 + 7) * 65 + n]);
      *reinterpret_cast<uint4*>(dst + (size_t)(n0 + n) * ld_dst + k0 + k8) = o;
    }
  }
  lds_barrier();
}

__device__ void phase_weights(const Params& p) {
  bf16* WA = (bf16*)(p.ws + WS_WA);
  bf16* WB = (bf16*)(p.ws + WS_WB);
  bf16* WPA = (bf16*)(p.ws + WS_WPA);
  bf16* WPB = (bf16*)(p.ws + WS_WPB);
  bf16* WOUT = (bf16*)(p.ws + WS_WOUT);
  bf16* WL = (bf16*)(p.ws + WS_WL);
  const int total = 768 + 256 + 16 + 256 + 256 + 512 + 256 + 256 + 256 + 128;
  for (int T = blockIdx.x; T < total; T += gridDim.x) {
    int x = T;
    if (x < 768) { tr_tile(IN(11), 6176, 0, 3072, WA, 1024, x & 15, x >> 4); continue; }
    x -= 768;
    if (x < 256) { tr_tile(IN(11), 6176, 4096, 1024, WA + (size_t)3072 * 1024, 1024, x & 15, x >> 4); continue; }
    x -= 256;
    if (x < 16) { tr_tile(IN(11), 6176, 6144, 32, WA + (size_t)4096 * 1024, 1024, x & 15, 0); continue; }
    x -= 16;
    if (x < 256) { tr_tile(IN(11), 6176, 3072, 1024, WB, 1024, x & 15, x >> 4); continue; }
    x -= 256;
    if (x < 256) { tr_tile(IN(11), 6176, 5120, 1024, WB + (size_t)1024 * 1024, 1024, x & 15, x >> 4); continue; }
    x -= 256;
    if (x < 512) { tr_tile(IN(33), 2048, 0, 2048, WB + (size_t)2048 * 1024, 1024, x & 15, x >> 4); continue; }
    x -= 512;
    if (x < 256) { tr_tile(IN(31), 1024, 0, 1024, WPA, 2048, x & 15, x >> 4); continue; }
    x -= 256;
    if (x < 256) { tr_tile(IN(32), 1024, 0, 1024, WPB, 2048, x & 15, x >> 4); continue; }
    x -= 256;
    if (x < 256) {
      tr_tile(IN(35), 1024, 0, 1024, WOUT, 2048, x & 15, x >> 4);
      tr_tile(IN(35), 1024, 0, 1024, WOUT + 1024, 2048, x & 15, x >> 4);
      continue;
    }
    x -= 256;
    {
      int sub = x >> 2, tt = x & 3;
      int type = sub >> 3, blk = sub & 7;
      const int widx[4] = {21, 23, 26, 28};
      const float* src = IN(type == 0 ? 21 : type == 1 ? 23 : type == 2 ? 26 : 28) + (size_t)blk * 128 * 128;
      (void)widx;
      tr_tile(src, 128, 0, 128, WL + ((size_t)blk * 512 + type * 128) * 128, 128, tt & 1, tt >> 1);
    }
  }
  {
    uint4 z = make_uint4(0, 0, 0, 0);
    uint4* dst = (uint4*)(WA + (size_t)4128 * 1024);
    const int n16 = 224 * 1024 * 2 / 16;
    for (int i = blockIdx.x * 512 + tid_l(); i < n16; i += gridDim.x * 512) dst[i] = z;
  }
}

__device__ void phase_h(const Params& p, bf16* H) {
  const int t_ = tid_l();
  const int lane = t_ & 63, wv = t_ >> 6;
  const float* nw = IN(8);
  const float* mod = (const float*)(p.ws + WS_MOD);
  auto process = [&](int R, const float4 (&v)[4]) {
    float ss = 0.f;
#pragma unroll
    for (int i = 0; i < 4; ++i) ss += v[i].x * v[i].x + v[i].y * v[i].y + v[i].z * v[i].z + v[i].w * v[i].w;
    for (int o = 32; o > 0; o >>= 1) ss += shfl_lane(ss, lane ^ o);
    const float rstd = rsqrtf(ss * (1.f / 1024.f) + 1e-6f);
    const float* md = mod + modidx(R) * 3072;
#pragma unroll
    for (int i = 0; i < 4; ++i) {
      const int c = (lane + 64 * i) * 4;
      float4 w4 = *(const float4*)(nw + c);
      float4 sh = *(const float4*)(md + c);
      float4 scl = *(const float4*)(md + 1024 + c);
      float h0 = v[i].x * rstd * w4.x * (1.f + scl.x) + sh.x;
      float h1 = v[i].y * rstd * w4.y * (1.f + scl.y) + sh.y;
      float h2 = v[i].z * rstd * w4.z * (1.f + scl.z) + sh.z;
      float h3 = v[i].w * rstd * w4.w * (1.f + scl.w) + sh.w;
      uint2 o;
      o.x = pack2(h0, h1);
      o.y = pack2(h2, h3);
      *(uint2*)(H + (size_t)R * 1024 + c) = o;
    }
  };
  const int stride = gridDim.x * 8;
  for (int R = blockIdx.x * 8 + wv; R < NTOK; R += 2 * stride) {
    const int R2 = R + stride;
    const bool has2 = R2 < NTOK;
    const float4* xa = (const float4*)xrow(p, R);
    const float4* xb2 = (const float4*)xrow(p, has2 ? R2 : R);
    float4 v[4], u[4];
#pragma unroll
    for (int i = 0; i < 4; ++i) v[i] = xa[lane + 64 * i];
#pragma unroll
    for (int i = 0; i < 4; ++i) u[i] = xb2[lane + 64 * i];
    process(R, v);
    if (has2) process(R2, u);
  }
}

__device__ __forceinline__ uint2 pack4(float a, float b, float c, float d) {
  uint2 o;
  o.x = pack2(a, b);
  o.y = pack2(c, d);
  return o;
}

__device__ void phase_gemm1a(const Params& p, const bf16* H, int g, int first, int stride) {
  const bf16* WA = (const bf16*)(p.ws + WS_WA);
  us* QKV = (us*)(p.ws + WS_QKV);
  us* XB = (us*)(p.ws + ((g & 1) ? WS_XB2 : WS_XB));
  float* GC = (float*)(p.ws + WS_GC);
  for (int T = first; T < 20 * 17; T += stride) {
    const int tm = T % 20, tn = T / 20;
    const int r0 = tm * 256, R0 = grow(g, r0);
    f32x4 acc[2][2][4][2];
    zero_acc(acc);
    gemm_tile(H + (size_t)R0 * 1024, 1024, WA + (size_t)tn * 256 * 1024, 1024, 1024, acc);
    if (tn < 12) {
      epilogue(acc, [&](int row, int c4, float4 v) {
        *(uint2*)(QKV + (size_t)(r0 + row) * 3072 + tn * 256 + c4) = pack4(v.x, v.y, v.z, v.w);
      });
    } else if (tn < 16) {
      epilogue(acc, [&](int row, int c4, float4 v) {
        *(uint2*)(XB + (size_t)(r0 + row) * 1024 + (tn - 12) * 256 + c4) = pack4(v.x, v.y, v.z, v.w);
      });
    } else {
      epilogue(acc, [&](int row, int c4, float4 v) {
        if (c4 < 32) *(float4*)(GC + (size_t)(r0 + row) * 32 + c4) = v;
      });
    }
  }
}

__device__ void phase_gemm1b(const Params& p, const bf16* H, int first, int stride, int mode) {
  const bf16* WB = (const bf16*)(p.ws + WS_WB);
  us* OCAT = (us*)(p.ws + WS_OCAT);
  us* GATE = (us*)(p.ws + WS_GATE);
  const float* bg = IN(34);
  const int ntile = mode == 0 ? 36 * 16 : 44 * 16;
  for (int T = first; T < ntile; T += stride) {
    const int tmi = T >> 4, tn = T & 15;
    const int tm = mode == 0 ? (tmi < 12 ? tmi : tmi + 4) : (tmi < 4 ? 12 + tmi : 36 + tmi);
    const int R0 = tm * 256;
    f32x4 acc[2][2][4][2];
    zero_acc(acc);
    gemm_tile(H + (size_t)R0 * 1024, 1024, WB + (size_t)tn * 256 * 1024, 1024, 1024, acc);
    epilogue(acc, [&](int row, int c4, float4 v) {
      if (tn < 8) {
        uint2* ptr = (uint2*)(OCAT + (size_t)(R0 + row) * 2048 + tn * 256 + c4);
        const uint2 o = *ptr;
        *ptr = pack4(__uint_as_float(o.x << 16) * siluf_(v.x), __uint_as_float(o.x & 0xffff0000u) * siluf_(v.y),
                     __uint_as_float(o.y << 16) * siluf_(v.z), __uint_as_float(o.y & 0xffff0000u) * siluf_(v.w));
      } else {
        const int gc = (tn - 8) * 256 + c4;
        const float4 b4 = *(const float4*)(bg + gc);
        *(uint2*)(GATE + (size_t)(R0 + row) * 2048 + gc) =
            pack4(sigmoidf_(v.x + b4.x), sigmoidf_(v.y + b4.y), sigmoidf_(v.z + b4.z), sigmoidf_(v.w + b4.w));
      }
    });
  }
}

__device__ void phase_gemm3(const Params& p, int T, int half) {
  const bf16* OCAT = (const bf16*)(p.ws + WS_OCAT);
  const bf16* WPA = (const bf16*)(p.ws + WS_WPA);
  const bf16* WPB = (const bf16*)(p.ws + WS_WPB);
  us* GATE = (us*)(p.ws + WS_GATE);
  {
    const int tm = T >> 2, tn = T & 3;
    const int R0 = tm * 256;
    {
      f32x4 acc[2][2][4][2];
      zero_acc(acc);
      const bf16* A = OCAT + (size_t)R0 * 2048 + half * 1024;
      const bf16* Bt = (half ? WPB : WPA) + (size_t)tn * 256 * 2048;
      gemm_tile(A, 2048, Bt, 2048, 1024, acc);
      epilogue(acc, [&](int row, int c4, float4 v) {
        us* base = GATE + (size_t)(R0 + row) * 2048 + tn * 256 + c4;
        const uint2 g = *(const uint2*)(base + half * 1024);
        float r0 = __uint_as_float(g.x << 16) * v.x, r1 = __uint_as_float(g.x & 0xffff0000u) * v.y;
        float r2 = __uint_as_float(g.y << 16) * v.z, r3 = __uint_as_float(g.y & 0xffff0000u) * v.w;
        if (half) {
          const uint2 m = *(const uint2*)base;
          r0 += __uint_as_float(m.x << 16); r1 += __uint_as_float(m.x & 0xffff0000u);
          r2 += __uint_as_float(m.y << 16); r3 += __uint_as_float(m.y & 0xffff0000u);
        }
        const uint2 pk = pack4(r0, r1, r2, r3);
        __hip_atomic_store((unsigned long long*)base, ((unsigned long long)pk.y << 32) | pk.x, __ATOMIC_RELAXED, __HIP_MEMORY_SCOPE_AGENT);
      });
    }
  }
}

__device__ void phase_gemm4(const Params& p, int first, int stride) {
  const bf16* TT = (const bf16*)(p.ws + WS_GATE);
  const bf16* WOUT2 = (const bf16*)(p.ws + WS_WOUT);
  const float* mod = (const float*)(p.ws + WS_MOD);
  for (int T = first; T < 80 * 4; T += stride) {
    const int tm = T >> 2, tn = T & 3;
    const int R0 = tm * 256, c0 = tn * 256;
    f32x4 acc[2][2][4][2];
    zero_acc(acc);
    gemm_tile(TT + (size_t)R0 * 2048, 2048, WOUT2 + (size_t)c0 * 2048, 2048, 1024, acc);
    const float* md = mod + modidx(R0) * 3072 + 2048;
    const float* xr = xrow(p, R0);
    epilogue(acc, [&](int row, int c4, float4 v) {
      const int c = c0 + c4;
      const float4 xv = *(const float4*)(xr + (size_t)row * 1024 + c);
      const float4 m4 = *(const float4*)(md + c);
      float4 o;
      o.x = xv.x + m4.x * v.x;
      o.y = xv.y + m4.y * v.y;
      o.z = xv.z + m4.z * v.z;
      o.w = xv.w + m4.w * v.w;
      *(float4*)(p.out + (size_t)(R0 + row) * 1024 + c) = o;
    });
  }
}

__device__ void phase_final(const Params& p) {
  const int t_ = tid_l();
  const int lane = t_ & 63, wv = t_ >> 6;
  const float* fw = IN(36);
  auto process = [&](int R, const float4 (&v)[4]) {
    float4* x4 = (float4*)(p.out + (size_t)R * 1024);
    float ss = 0.f;
#pragma unroll
    for (int i = 0; i < 4; ++i) ss += v[i].x * v[i].x + v[i].y * v[i].y + v[i].z * v[i].z + v[i].w * v[i].w;
    for (int o = 32; o > 0; o >>= 1) ss += shfl_lane(ss, lane ^ o);
    const float rstd = rsqrtf(ss * (1.f / 1024.f) + 1e-6f);
#pragma unroll
    for (int i = 0; i < 4; ++i) {
      float4 w4 = *(const float4*)(fw + (lane + 64 * i) * 4);
      float4 o;
      o.x = v[i].x * rstd * w4.x;
      o.y = v[i].y * rstd * w4.y;
      o.z = v[i].z * rstd * w4.z;
      o.w = v[i].w * rstd * w4.w;
      x4[lane + 64 * i] = o;
    }
  };
  const int stride = gridDim.x * 8;
  for (int R = blockIdx.x * 8 + wv; R < NTOK; R += 2 * stride) {
    const int R2 = R + stride;
    const bool has2 = R2 < NTOK;
    const float4* xa = (const float4*)(p.out + (size_t)R * 1024);
    const float4* xb2 = (const float4*)(p.out + (size_t)(has2 ? R2 : R) * 1024);
    float4 v[4], u[4];
#pragma unroll
    for (int i = 0; i < 4; ++i) v[i] = xa[lane + 64 * i];
#pragma unroll
    for (int i = 0; i < 4; ++i) u[i] = xb2[lane + 64 * i];
    process(R, v);
    if (has2) process(R2, u);
  }
}

#if PROBE_MASK
#define PTICK(B) { long long tq1_ = wall_clock64(); if ((PROBE_MASK >> (B)) & 1) tacc += tq1_ - tq0_; tq0_ = tq1_; }
#define PT0() long long tq0_ = wall_clock64();
#else
#define PTICK(B)
#define PT0()
#endif
__device__ __forceinline__ bf16x8 ld8(const us* ptr) { return *reinterpret_cast<const bf16x8*>(ptr); }

__device__ void gdn_prep_item(const Params& p, int item, long long& tacc) {
  PT0()
  const int t = tid_l(), lane = t & 63, w = t >> 6;
  const int tc = item >> 3, h = item & 7;
  const int r0 = tc * 64;
  int seq_lo, seq_hi;
  if (tc < 16) { seq_lo = (tc >> 2) * 256; seq_hi = seq_lo + 256; } else { seq_lo = 1024; seq_hi = 5120; }
  const int ci = item;

  char* L = (char*)shm;
  us* qs = (us*)L;
  us* ks = (us*)(L + 17408);
  float* AF = (float*)L;
  float* ABF = (float*)(L + 17408);
  us* kTb = (us*)(L + 34816);
  us* vTb = (us*)(L + 53248);
  float* vec = (float*)(L + 71680);
  float* Gv = vec;
  float* Bv = vec + 128;
  float* SCL = vec + 256;

  const us* QKV = (const us*)(p.ws + WS_QKV);
  const float* GC = (const float*)(p.ws + WS_GC);

  float* cwl2 = (float*)(L + 131072);
  if (t < 480) {
    const int rw = t / 96, rem = t - rw * 96, m = rem >> 5, c4 = (rem & 31) * 4;
    const float* srcw = rw < 4 ? IN(12) + rw * 3072 + m * 1024 + h * 128 + c4 : IN(13) + m * 1024 + h * 128 + c4;
    *(float4*)(cwl2 + rw * 384 + m * 128 + c4) = *(const float4*)srcw;
  }
  if (w == 0) {
    const int i = lane;
    const float* gc = GC + (size_t)(r0 + i) * 32;
    float af = gc[h], bfv = gc[8 + h], ab = gc[16 + h], bb = gc[24 + h];
    float gf = -__expf(IN(14)[h]) * softplusf_(af + IN(15)[h]);
    float gb = -__expf(IN(16)[h]) * softplusf_(ab + IN(17)[h]);
    float betaf = sigmoidf_(bfv), betab = sigmoidf_(bb);
    float s = gf;
    for (int o = 1; o < 64; o <<= 1) {
      float y = shfl_lane(s, lane >= o ? lane - o : lane);
      if (lane >= o) s += y;
    }
    float s2 = gb;
    for (int o = 1; o < 64; o <<= 1) {
      float y = shfl_lane(s2, lane + o < 64 ? lane + o : lane);
      if (lane + o < 64) s2 += y;
    }
    float glf = shfl_lane(s, 63), glb = shfl_lane(s2, 0);
    Gv[i] = s; Gv[64 + i] = s2;
    Bv[i] = betaf; Bv[64 + i] = betab;
    float egf = __expf(s), egb = __expf(s2);
    SCL[i] = betaf; SCL[64 + i] = betaf * egf; SCL[128 + i] = betab; SCL[192 + i] = betab * egb;
    float* EG = (float*)(p.ws + WS_EG);
    float* ES = (float*)(p.ws + WS_ES);
    float* DL = (float*)(p.ws + WS_DL);
    EG[(size_t)(ci * 2 + 0) * 64 + i] = egf;
    EG[(size_t)(ci * 2 + 1) * 64 + i] = egb;
    ES[(size_t)(ci * 2 + 0) * 64 + i] = __expf(glf - s);
    ES[(size_t)(ci * 2 + 1) * 64 + i] = __expf(glb - s2);
    if (i == 0) { DL[ci * 2 + 0] = __expf(glf); DL[ci * 2 + 1] = __expf(glb); }
  }
  lds_barrier();
  {
    const int i = t >> 3, cg8 = t & 7;
#pragma unroll
    for (int m = 0; m < 3; ++m) {
      const int col = m * 1024 + h * 128 + cg8 * 16;
      const float* cwm = cwl2 + m * 128 + cg8 * 16;
      float y[16];
#pragma unroll
      for (int c = 0; c < 16; ++c) y[c] = cwm[4 * 384 + c];
#pragma unroll
      for (int tap = 0; tap < 4; ++tap) {
        const int rr = r0 + i - 2 + tap;
        if (rr >= seq_lo && rr < seq_hi) {
          const uint4* src = (const uint4*)(QKV + (size_t)rr * 3072 + col);
          uint4 a = src[0], b = src[1];
          unsigned wds[8] = {a.x, a.y, a.z, a.w, b.x, b.y, b.z, b.w};
          const float* wt = cwm + tap * 384;
#pragma unroll
          for (int c = 0; c < 8; ++c) {
            y[2 * c] += wt[2 * c] * __uint_as_float(wds[c] << 16);
            y[2 * c + 1] += wt[2 * c + 1] * __uint_as_float(wds[c] & 0xffff0000u);
          }
        }
      }
      float ss = 0.f;
#pragma unroll
      for (int c = 0; c < 16; ++c) { y[c] = siluf_(y[c]); ss += y[c] * y[c]; }
      if (m < 2) {
        ss += shfl_lane(ss, lane ^ 1);
        ss += shfl_lane(ss, lane ^ 2);
        ss += shfl_lane(ss, lane ^ 4);
        float inv = rsqrtf(ss + 1e-6f);
        if (m == 0) inv *= 0.08838834764831845f;
#pragma unroll
        for (int c = 0; c < 16; ++c) y[c] *= inv;
      }
      if (m == 0) {
        uint4 o0, o1;
        o0.x = pack2(y[0], y[1]); o0.y = pack2(y[2], y[3]); o0.z = pack2(y[4], y[5]); o0.w = pack2(y[6], y[7]);
        o1.x = pack2(y[8], y[9]); o1.y = pack2(y[10], y[11]); o1.z = pack2(y[12], y[13]); o1.w = pack2(y[14], y[15]);
        *(uint4*)(qs + i * 136 + cg8 * 16) = o0;
        *(uint4*)(qs + i * 136 + cg8 * 16 + 8) = o1;
        us* Qg = (us*)(p.ws + WS_Q) + (size_t)ci * 8192 + i * 128 + cg8 * 16;
        *(uint4*)Qg = o0;
        *(uint4*)(Qg + 8) = o1;
      } else if (m == 1) {
        uint4 o0, o1;
        o0.x = pack2(y[0], y[1]); o0.y = pack2(y[2], y[3]); o0.z = pack2(y[4], y[5]); o0.w = pack2(y[6], y[7]);
        o1.x = pack2(y[8], y[9]); o1.y = pack2(y[10], y[11]); o1.z = pack2(y[12], y[13]); o1.w = pack2(y[14], y[15]);
        *(uint4*)(ks + i * 136 + cg8 * 16) = o0;
        *(uint4*)(ks + i * 136 + cg8 * 16 + 8) = o1;
#pragma unroll
        for (int c = 0; c < 16; ++c) kTb[(cg8 * 16 + c) * 72 + i] = f2bf(y[c]);
      } else {
#pragma unroll
        for (int c = 0; c < 16; ++c) vTb[(cg8 * 16 + c) * 72 + i] = f2bf(y[c]);
      }
    }
  }
  lds_barrier();
  PTICK(13)
  f32x4 acc[4];
  {
    const int mat = w >> 2, mt = w & 3;
    const us* Asrc = mat == 0 ? ks : qs;
#pragma unroll
    for (int n = 0; n < 4; ++n) acc[n] = f32x4{0.f, 0.f, 0.f, 0.f};
#pragma unroll
    for (int kk = 0; kk < 4; ++kk) {
      bf16x8 a = ld8(Asrc + (16 * mt + (lane & 15)) * 136 + kk * 32 + (lane >> 4) * 8);
#pragma unroll
      for (int n = 0; n < 4; ++n) {
        bf16x8 b = ld8(ks + (16 * n + (lane & 15)) * 136 + kk * 32 + (lane >> 4) * 8);
        acc[n] = __builtin_amdgcn_mfma_f32_16x16x32_bf16(a, b, acc[n], 0, 0, 0);
      }
    }
  }
  lds_barrier();
  {
    const int mat = w >> 2, mt = w & 3;
    us* QKM = (us*)(p.ws + WS_QKM);
#pragma unroll
    for (int n = 0; n < 4; ++n)
#pragma unroll
      for (int jj = 0; jj < 4; ++jj) {
        const int i = 16 * mt + 4 * (lane >> 4) + jj, j = 16 * n + (lane & 15);
        const float val = acc[n][jj];
        const float df = __expf(Gv[i] - Gv[j]);
        const float db = __expf(Gv[64 + i] - Gv[64 + j]);
        if (mat == 0) {
          AF[i * 68 + j] = (i > j) ? Bv[i] * val * df : 0.f;
          ABF[(63 - i) * 68 + (63 - j)] = (i < j) ? Bv[64 + i] * val * db : 0.f;
        } else {
          QKM[(size_t)(ci * 2 + 0) * 4096 + i * 64 + j] = f2bf((i >= j) ? val * df : 0.f);
          QKM[(size_t)(ci * 2 + 1) * 4096 + i * 64 + j] = f2bf((i <= j) ? val * db : 0.f);
        }
      }
  }
  {
    us* KT = (us*)(p.ws + WS_KT) + (size_t)ci * 8192;
    for (int idx = t; idx < 8192; idx += 512) KT[idx] = kTb[(idx >> 6) * 72 + (idx & 63)];
  }
  lds_barrier();
  PTICK(14)
  {
    const int d = w >> 2, wq = w & 3, lr = lane & 15, lq = lane >> 4;
    const float* Am = d ? ABF : AF;
    us* Sm = (us*)(L + 73728 + d * 27648);
    us* STm = Sm + 4608;
    us* Pm = STm + 4608;
    f32x4 Pacc[4], Sn[4];
#pragma unroll
    for (int nt = 0; nt < 4; ++nt)
#pragma unroll
      for (int jj = 0; jj < 4; ++jj) {
        const int row = 16 * wq + 4 * lq + jj, col = 16 * nt + lr;
        const float av = Am[row * 68 + col];
        Sn[nt][jj] = av;
        Pacc[nt][jj] = (row == col ? 1.f : 0.f) - av;
      }
    auto write_S = [&]() {
#pragma unroll
      for (int nt = 0; nt < 4; ++nt) {
        const int col = 16 * nt + lr, row0 = 16 * wq + 4 * lq;
#pragma unroll
        for (int jj = 0; jj < 4; ++jj) Sm[(row0 + jj) * 72 + col] = f2bf(Sn[nt][jj]);
        uint2 o;
        o.x = pack2(Sn[nt][0], Sn[nt][1]);
        o.y = pack2(Sn[nt][2], Sn[nt][3]);
        *(uint2*)(STm + col * 72 + row0) = o;
      }
    };
    auto write_P = [&]() {
#pragma unroll
      for (int nt = 0; nt < 4; ++nt) {
        const int col = 16 * nt + lr, row0 = 16 * wq + 4 * lq;
#pragma unroll
        for (int jj = 0; jj < 4; ++jj) Pm[(row0 + jj) * 72 + col] = f2bf(Pacc[nt][jj]);
      }
    };
    write_S();
    write_P();
    lds_barrier();
    {
      f32x4 acc2[4];
#pragma unroll
      for (int nt = 0; nt < 4; ++nt) acc2[nt] = f32x4{0.f, 0.f, 0.f, 0.f};
#pragma unroll
      for (int kk = 0; kk < 2; ++kk) {
        bf16x8 af = ld8(Sm + (16 * wq + lr) * 72 + kk * 32 + lq * 8);
#pragma unroll
        for (int nt = 0; nt < 4; ++nt) {
          bf16x8 bfr = ld8(STm + (16 * nt + lr) * 72 + kk * 32 + lq * 8);
          acc2[nt] = __builtin_amdgcn_mfma_f32_16x16x32_bf16(af, bfr, acc2[nt], 0, 0, 0);
        }
      }
#pragma unroll
      for (int nt = 0; nt < 4; ++nt) Sn[nt] = acc2[nt];
    }
    lds_barrier();
    write_S();
#pragma unroll 1
    for (int k = 1; k <= 5; ++k) {
      lds_barrier();
      f32x4 acc2[4];
#pragma unroll
      for (int nt = 0; nt < 4; ++nt) acc2[nt] = f32x4{0.f, 0.f, 0.f, 0.f};
#pragma unroll
      for (int kk = 0; kk < 2; ++kk) {
        bf16x8 pf = ld8(Pm + (16 * wq + lr) * 72 + kk * 32 + lq * 8);
        bf16x8 sf = ld8(Sm + (16 * wq + lr) * 72 + kk * 32 + lq * 8);
#pragma unroll
        for (int nt = 0; nt < 4; ++nt) {
          bf16x8 bfr = ld8(STm + (16 * nt + lr) * 72 + kk * 32 + lq * 8);
          Pacc[nt] = __builtin_amdgcn_mfma_f32_16x16x32_bf16(pf, bfr, Pacc[nt], 0, 0, 0);
          acc2[nt] = __builtin_amdgcn_mfma_f32_16x16x32_bf16(sf, bfr, acc2[nt], 0, 0, 0);
        }
      }
#pragma unroll
      for (int nt = 0; nt < 4; ++nt) Sn[nt] = acc2[nt];
      lds_barrier();
      if (k < 5) {
        write_S();
        write_P();
      }
    }
    {
#pragma unroll
      for (int nt = 0; nt < 4; ++nt)
#pragma unroll
        for (int jj = 0; jj < 4; ++jj) {
          Pacc[nt][jj] = bf2f(f2bf(Pacc[nt][jj]));
          Sn[nt][jj] = Pacc[nt][jj];
        }
      write_S();
      lds_barrier();
      f32x4 Racc[4];
#pragma unroll
      for (int nt = 0; nt < 4; ++nt)
#pragma unroll
        for (int jj = 0; jj < 4; ++jj) Racc[nt][jj] = ((16 * wq + 4 * lq + jj) == (16 * nt + lr)) ? 1.f : 0.f;
#pragma unroll
      for (int kk = 0; kk < 2; ++kk) {
        const int rr = 16 * wq + lr, k0 = kk * 32 + lq * 8;
        const float* ar = Am + rr * 68 + k0;
        bf16x8 hi, lo;
#pragma unroll
        for (int e = 0; e < 8; ++e) {
          const float lv = -(ar[e] + (rr == k0 + e ? 1.f : 0.f));
          const us hb = f2bf(lv);
          hi[e] = (short)hb;
          lo[e] = (short)f2bf(lv - bf2f(hb));
        }
#pragma unroll
        for (int nt = 0; nt < 4; ++nt) {
          bf16x8 bfr = ld8(STm + (16 * nt + lr) * 72 + kk * 32 + lq * 8);
          Racc[nt] = __builtin_amdgcn_mfma_f32_16x16x32_bf16(hi, bfr, Racc[nt], 0, 0, 0);
          Racc[nt] = __builtin_amdgcn_mfma_f32_16x16x32_bf16(lo, bfr, Racc[nt], 0, 0, 0);
        }
      }
#pragma unroll
      for (int nt = 0; nt < 4; ++nt) {
        uint2 o;
        o.x = pack2(Racc[nt][0], Racc[nt][1]);
        o.y = pack2(Racc[nt][2], Racc[nt][3]);
        *(uint2*)(Pm + (16 * nt + lr) * 72 + 16 * wq + 4 * lq) = o;
      }
      lds_barrier();
#pragma unroll
      for (int kk = 0; kk < 2; ++kk) {
        bf16x8 af = ld8(Sm + (16 * wq + lr) * 72 + kk * 32 + lq * 8);
#pragma unroll
        for (int nt = 0; nt < 4; ++nt) {
          bf16x8 bfr = ld8(Pm + (16 * nt + lr) * 72 + kk * 32 + lq * 8);
          Pacc[nt] = __builtin_amdgcn_mfma_f32_16x16x32_bf16(af, bfr, Pacc[nt], 0, 0, 0);
        }
      }
      lds_barrier();
    }
    {
      const float* sclU = SCL + (d * 2 + 0) * 64;
      const float* sclW = SCL + (d * 2 + 1) * 64;
#pragma unroll
      for (int nt = 0; nt < 4; ++nt)
#pragma unroll
        for (int jj = 0; jj < 4; ++jj) {
          const int ip = 16 * wq + 4 * lq + jj, jp = 16 * nt + lr;
          const int i = d ? 63 - ip : ip, j = d ? 63 - jp : jp;
          const float tv = Pacc[nt][jj];
          Sm[i * 72 + j] = f2bf(tv * sclU[j]);
          STm[i * 72 + j] = f2bf(tv * sclW[j]);
        }
    }
    lds_barrier();
    PTICK(15)
#pragma unroll 1
    for (int isW = 0; isW < 2; ++isW) {
      const us* Tm = isW ? STm : Sm;
      const us* Bm = isW ? kTb : vTb;
      f32x4 accU[8];
#pragma unroll
      for (int nt = 0; nt < 8; ++nt) accU[nt] = f32x4{0.f, 0.f, 0.f, 0.f};
#pragma unroll
      for (int kk = 0; kk < 2; ++kk) {
        bf16x8 af = ld8(Tm + (16 * wq + lr) * 72 + kk * 32 + lq * 8);
#pragma unroll
        for (int nt = 0; nt < 8; ++nt) {
          bf16x8 bfr = ld8(Bm + (16 * nt + lr) * 72 + kk * 32 + lq * 8);
          accU[nt] = __builtin_amdgcn_mfma_f32_16x16x32_bf16(af, bfr, accU[nt], 0, 0, 0);
        }
      }
      us* dst = (us*)(p.ws + (isW ? WS_WN : WS_U)) + (size_t)(ci * 2 + d) * 8192;
      if (isW) {
#pragma unroll
        for (int nt = 0; nt < 8; ++nt)
#pragma unroll
          for (int jj = 0; jj < 4; ++jj) dst[(16 * wq + 4 * lq + jj) * 128 + 16 * nt + lr] = f2bf(-accU[nt][jj]);
      } else {
#pragma unroll
        for (int sl2 = 0; sl2 < 4; ++sl2) {
          uint4 o;
          o.x = pack2(accU[2 * sl2][0], accU[2 * sl2][1]);
          o.y = pack2(accU[2 * sl2][2], accU[2 * sl2][3]);
          o.z = pack2(accU[2 * sl2 + 1][0], accU[2 * sl2 + 1][1]);
          o.w = pack2(accU[2 * sl2 + 1][2], accU[2 * sl2 + 1][3]);
          *(uint4*)(dst + ((sl2 * 4 + wq) * 64 + lane) * 8) = o;
        }
      }
    }
  }
  lds_barrier();
  PTICK(16)
}

__device__ void gdn_seq_item(const Params& p, int g, int item, us* OF, us* OB) {
  const int t = tid_l(), lane = t & 63, w = __builtin_amdgcn_readfirstlane(t >> 6);
  int h, d, sl, tc0, nch, seq = -1;
  if (item < 64) { h = item >> 3; d = (item >> 2) & 1; sl = item & 3; tc0 = 16; nch = 64; }
  else { int it = item - 64; seq = it >> 6; int rem = it & 63; h = rem >> 3; d = (rem >> 2) & 1; sl = rem & 3; tc0 = seq * 4; nch = 4; }
  char* L = (char*)shm;
  us* sT = (us*)L;
  us* vT = (us*)(L + 8704);
  us* vsT = (us*)(L + 8704 + 4608);
  const us* Qb = (const us*)(p.ws + WS_Q);
  const us* KTb = (const us*)(p.ws + WS_KT);
  const us* WNb = (const us*)(p.ws + WS_WN);
  const us* Ub = (const us*)(p.ws + WS_U);
  const us* QKMb = (const us*)(p.ws + WS_QKM);
  const float* EG = (const float*)(p.ws + WS_EG);
  const float* ES = (const float*)(p.ws + WS_ES);
  const float* DL = (const float*)(p.ws + WS_DL);
  us* O = d ? OB : OF;
  const int lr = lane & 15, lq = lane >> 4;

  f32x4 s[2];
  if (seq < 0) {
    const float* st = IN(d ? 3 : 2) + ((size_t)(g * 8 + h) * 128) * 128;
#pragma unroll
    for (int nt = 0; nt < 2; ++nt)
#pragma unroll
      for (int jj = 0; jj < 4; ++jj) s[nt][jj] = st[(size_t)(16 * w + 4 * lq + jj) * 128 + sl * 32 + 16 * nt + lr];
  } else {
    s[0] = f32x4{0.f, 0.f, 0.f, 0.f};
    s[1] = f32x4{0.f, 0.f, 0.f, 0.f};
  }
  lds_barrier();
#pragma unroll
  for (int nt = 0; nt < 2; ++nt) {
    uint2 o;
    o.x = pack2(s[nt][0], s[nt][1]);
    o.y = pack2(s[nt][2], s[nt][3]);
    *(uint2*)(sT + (16 * nt + lr) * 136 + 16 * w + 4 * lq) = o;
  }
  lds_barrier();

  struct Ops {
    bf16x8 a[4];
    bf16x8 qk[2];
    bf16x8 kt[2];
    uint4 u;
    float e[4];
    float dl;
  };
  const int mt = w & 3;
  auto load_a = [&](int step, Ops& o) {
    const int c = d ? nch - 1 - step : step;
    const int tc = tc0 + c;
    const int ci = tc * 8 + h, cd = ci * 2 + d;
    const us* Ap = (w < 4) ? (WNb + (size_t)cd * 8192) : (Qb + (size_t)ci * 8192);
#pragma unroll
    for (int kk = 0; kk < 4; ++kk) o.a[kk] = ld8(Ap + (16 * mt + lr) * 128 + kk * 32 + lq * 8);
    if (w < 4) {
      o.u = *(const uint4*)(Ub + (size_t)cd * 8192 + ((sl * 4 + mt) * 64 + lane) * 8);
      const float4 e4 = *(const float4*)(ES + (size_t)cd * 64 + 16 * mt + 4 * lq);
      o.e[0] = e4.x; o.e[1] = e4.y; o.e[2] = e4.z; o.e[3] = e4.w;
    } else {
      const float4 e4 = *(const float4*)(EG + (size_t)cd * 64 + 16 * mt + 4 * lq);
      o.e[0] = e4.x; o.e[1] = e4.y; o.e[2] = e4.z; o.e[3] = e4.w;
    }
  };
  auto load_b = [&](int step, Ops& o) {
    const int c = d ? nch - 1 - step : step;
    const int tc = tc0 + c;
    const int ci = tc * 8 + h, cd = ci * 2 + d;
    const us* Kp = KTb + (size_t)ci * 8192;
#pragma unroll
    for (int kk = 0; kk < 2; ++kk) o.kt[kk] = ld8(Kp + (16 * w + lr) * 64 + kk * 32 + lq * 8);
    o.dl = DL[cd];
    if (w >= 4) {
      const us* Qp = QKMb + (size_t)cd * 4096;
#pragma unroll
      for (int kk = 0; kk < 2; ++kk) o.qk[kk] = ld8(Qp + (16 * mt + lr) * 64 + kk * 32 + lq * 8);
    }
  };
  Ops ring[4];
  load_a(0, ring[0]); load_b(0, ring[0]);
  load_a(1, ring[1]); load_b(1, ring[1]);
  load_a(2, ring[2]); load_b(2, ring[2]);
  auto do_step = [&](int step, int tc, int nstep, auto STc) {
    constexpr int ST = decltype(STc)::value;
    f32x4 acc[2];
    {
      if (w < 4) {
        const uint4 uu = ring[ST].u;
        acc[0][0] = __uint_as_float(uu.x << 16); acc[0][1] = __uint_as_float(uu.x & 0xffff0000u);
        acc[0][2] = __uint_as_float(uu.y << 16); acc[0][3] = __uint_as_float(uu.y & 0xffff0000u);
        acc[1][0] = __uint_as_float(uu.z << 16); acc[1][1] = __uint_as_float(uu.z & 0xffff0000u);
        acc[1][2] = __uint_as_float(uu.w << 16); acc[1][3] = __uint_as_float(uu.w & 0xffff0000u);
      } else {
        acc[0] = f32x4{0.f, 0.f, 0.f, 0.f};
        acc[1] = f32x4{0.f, 0.f, 0.f, 0.f};
      }
#pragma unroll
      for (int kk = 0; kk < 4; ++kk)
#pragma unroll
        for (int nt = 0; nt < 2; ++nt) {
          bf16x8 b = ld8(sT + (16 * nt + lr) * 136 + kk * 32 + lq * 8);
          acc[nt] = __builtin_amdgcn_mfma_f32_16x16x32_bf16(ring[ST].a[kk], b, acc[nt], 0, 0, 0);
        }
    }
    if (w < 4) {
#pragma unroll
      for (int nt = 0; nt < 2; ++nt) {
        uint2 o, o2;
        o.x = pack2(acc[nt][0], acc[nt][1]);
        o.y = pack2(acc[nt][2], acc[nt][3]);
        o2.x = pack2(acc[nt][0] * ring[ST].e[0], acc[nt][1] * ring[ST].e[1]);
        o2.y = pack2(acc[nt][2] * ring[ST].e[2], acc[nt][3] * ring[ST].e[3]);
        *(uint2*)(vT + (16 * nt + lr) * 72 + 16 * mt + 4 * lq) = o;
        *(uint2*)(vsT + (16 * nt + lr) * 72 + 16 * mt + 4 * lq) = o2;
      }
    }
    lds_barrier();
    load_b(nstep, ring[(ST + 3) & 3]);
    if (w >= 4) {
#pragma unroll
      for (int nt = 0; nt < 2; ++nt)
#pragma unroll
        for (int jj = 0; jj < 4; ++jj) acc[nt][jj] *= ring[ST].e[jj];
#pragma unroll
      for (int kk = 0; kk < 2; ++kk) {
#pragma unroll
        for (int nt = 0; nt < 2; ++nt) {
          bf16x8 b = ld8(vT + (16 * nt + lr) * 72 + kk * 32 + lq * 8);
          acc[nt] = __builtin_amdgcn_mfma_f32_16x16x32_bf16(ring[ST].qk[kk], b, acc[nt], 0, 0, 0);
        }
      }
      const int rbase = tc * 64 + 16 * mt + 4 * lq;
#pragma unroll
      for (int nt = 0; nt < 2; ++nt)
#pragma unroll
        for (int jj = 0; jj < 4; ++jj) O[(size_t)(rbase + jj) * 1024 + h * 128 + sl * 32 + 16 * nt + lr] = f2bf(acc[nt][jj]);
    }
    {
#pragma unroll
      for (int nt = 0; nt < 2; ++nt)
#pragma unroll
        for (int jj = 0; jj < 4; ++jj) s[nt][jj] *= ring[ST].dl;
#pragma unroll
      for (int kk = 0; kk < 2; ++kk) {
#pragma unroll
        for (int nt = 0; nt < 2; ++nt) {
          bf16x8 b = ld8(vsT + (16 * nt + lr) * 72 + kk * 32 + lq * 8);
          s[nt] = __builtin_amdgcn_mfma_f32_16x16x32_bf16(ring[ST].kt[kk], b, s[nt], 0, 0, 0);
        }
      }
#pragma unroll
      for (int nt = 0; nt < 2; ++nt) {
        uint2 o;
        o.x = pack2(s[nt][0], s[nt][1]);
        o.y = pack2(s[nt][2], s[nt][3]);
        *(uint2*)(sT + (16 * nt + lr) * 136 + 16 * w + 4 * lq) = o;
      }
    }
    lds_barrier();
  };
  for (int step0 = 0; step0 < nch; step0 += 4) {
#define SEQ_SUB(K)                                                                 \
    {                                                                              \
      const int step = step0 + K;                                                  \
      const int c = d ? nch - 1 - step : step;                                     \
      const int nstep = step + 3 < nch ? step + 3 : nch - 1;                       \
      load_a(nstep, ring[(K + 3) & 3]);                                            \
      do_step(step, tc0 + c, nstep, std::integral_constant<int, K>{});             \
    }
    SEQ_SUB(0) SEQ_SUB(1) SEQ_SUB(2) SEQ_SUB(3)
#undef SEQ_SUB
  }
  if (seq >= 0) {
    const int b = g * 4 + seq;
    float* dst = p.out + (d ? OUT_SAB : OUT_SAF) + ((size_t)(b * 8 + h) * 128) * 128;
#pragma unroll
    for (int nt = 0; nt < 2; ++nt)
#pragma unroll
      for (int jj = 0; jj < 4; ++jj) dst[(size_t)(16 * w + 4 * lq + jj) * 128 + sl * 32 + 16 * nt + lr] = s[nt][jj];
  }
}

__device__ __forceinline__ int lru_row(int sc, int jj) {
  if (sc < 16) {
    int j = (sc & 3) * 64 + jj;
    if (j < 0 || j >= 256) return -1;
    return (sc >> 2) * 256 + j;
  } else {
    int j = (sc - 16) * 64 + jj;
    if (j < 0 || j >= 4096) return -1;
    return 1024 + (j & 63) * 64 + (j >> 6);
  }
}

__device__ void lru_item(const Params& p, int g, int item, int pass, long long& tacc) {
  PT0()
  const int t = tid_l(), lane = t & 63, w = t >> 6;
  const int sc = item >> 3, blk = item & 7;
  const int lr = lane & 15, lq = lane >> 4;
  char* L = (char*)shm;
  constexpr int LS = 132;
  float* xcf = (float*)L;
  float* Aa = (float*)(L + 33792);
  float* Bb = (float*)(L + 67584);
  float* HF = (float*)(L + 101376);
  us* xcb = (us*)(L + 101376);
  float* carry = (float*)(L + 135168);
  float* stage = (float*)(L + 33792);
  const us* XB = (const us*)(p.ws + ((g & 1) ? WS_XB2 : WS_XB));
  float* AGG = (float*)(p.ws + WS_AGG);
  const int cidx = sc < 16 ? (sc & 3) : sc - 16;
  const int nch = sc < 16 ? 4 : 64;
  const int sc0 = sc < 16 ? (sc & ~3) : 16;

  bf16x8 wfr[4][4];
  float prm[2][3];
  {
    const us* WL = (const us*)(p.ws + WS_WL) + (size_t)blk * 512 * 128;
#pragma unroll
    for (int kk = 0; kk < 4; ++kk)
#pragma unroll
      for (int ty = 0; ty < 4; ++ty) wfr[kk][ty] = ld8(WL + (size_t)(ty * 128 + 16 * w + lr) * 128 + kk * 32 + lq * 8);
    const int chp = blk * 128 + 16 * w + lr;
    prm[0][0] = IN(22)[chp]; prm[0][1] = IN(24)[chp]; prm[0][2] = IN(25)[chp];
    prm[1][0] = IN(27)[chp]; prm[1][1] = IN(29)[chp]; prm[1][2] = IN(30)[chp];
  }
  float* cwl = (float*)(L + 140288);
  float4 cwv = make_float4(0.f, 0.f, 0.f, 0.f);
  if (t < 160) {
    const int rw = t >> 5, c4 = (t & 31) * 4;
    const float* srcw = rw < 4 ? IN(19) + rw * 1024 + blk * 128 + c4 : IN(20) + blk * 128 + c4;
    cwv = *(const float4*)srcw;
  }
  lds_barrier();
  if (t < 160) *(float4*)(cwl + t * 4) = cwv;
  if (pass == 1) {
    const int nf = cidx, nb = nch - 1 - cidx;
    for (int idx = t; idx < (nf + nb) * 64; idx += 512) {
      int e = idx >> 6, rem = idx & 63, ab = rem >> 5, c4 = (rem & 31) * 4;
      int cp, dir;
      if (e < nf) { cp = e; dir = 0; } else { cp = nch - 1 - (e - nf); dir = 1; }
      *(float4*)(stage + e * 256 + ab * 128 + c4) =
          *(const float4*)(AGG + ((size_t)((sc0 + cp) * 2 + dir) * 2 + ab) * 1024 + blk * 128 + c4);
    }
    lds_barrier();
    if (t < 256) {
      const int dir = t >> 7, ch = t & 127;
      float hh = 0.f;
      if (sc >= 16) hh = IN(dir ? 5 : 4)[(size_t)g * 1024 + blk * 128 + ch];
      const int e0 = dir ? nf : 0, ne = dir ? nb : nf;
      for (int e = 0; e < ne; ++e) hh = stage[(e0 + e) * 256 + ch] * hh + stage[(e0 + e) * 256 + 128 + ch];
      carry[dir * 128 + ch] = hh;
    }
    lds_barrier();
  }
  PTICK(17)
  lds_barrier();
  {
    const int pp = t >> 3, cg8 = t & 7;
    const int chg = blk * 128 + cg8 * 16;
    float y[16];
#pragma unroll
    for (int c = 0; c < 16; ++c) y[c] = cwl[4 * 128 + cg8 * 16 + c];
#pragma unroll
    for (int tap = 0; tap < 4; ++tap) {
      const int row = lru_row(sc, pp - 2 + tap);
      if (row >= 0) {
        const uint4* src = (const uint4*)(XB + (size_t)row * 1024 + chg);
        uint4 a = src[0], b = src[1];
        unsigned wds[8] = {a.x, a.y, a.z, a.w, b.x, b.y, b.z, b.w};
        const float* wt = cwl + tap * 128 + cg8 * 16;
#pragma unroll
        for (int c = 0; c < 8; ++c) {
          y[2 * c] += wt[2 * c] * __uint_as_float(wds[c] << 16);
          y[2 * c + 1] += wt[2 * c + 1] * __uint_as_float(wds[c] & 0xffff0000u);
        }
      }
    }
#pragma unroll
    for (int c = 0; c < 16; ++c) xcf[pp * LS + cg8 * 16 + c] = y[c];
    uint4 o0, o1;
    o0.x = pack2(y[0], y[1]); o0.y = pack2(y[2], y[3]); o0.z = pack2(y[4], y[5]); o0.w = pack2(y[6], y[7]);
    o1.x = pack2(y[8], y[9]); o1.y = pack2(y[10], y[11]); o1.z = pack2(y[12], y[13]); o1.w = pack2(y[14], y[15]);
    *(uint4*)(xcb + pp * 136 + cg8 * 16) = o0;
    *(uint4*)(xcb + pp * 136 + cg8 * 16 + 8) = o1;
  }
  lds_barrier();
  PTICK(18)
  f32x4 acc[4][4];
  {
#pragma unroll
    for (int ty = 0; ty < 4; ++ty)
#pragma unroll
      for (int m = 0; m < 4; ++m) acc[ty][m] = f32x4{0.f, 0.f, 0.f, 0.f};
#pragma unroll
    for (int kk = 0; kk < 4; ++kk) {
      bf16x8 a[4];
#pragma unroll
      for (int m = 0; m < 4; ++m) a[m] = ld8(xcb + (16 * m + lr) * 136 + kk * 32 + lq * 8);
#pragma unroll
      for (int ty = 0; ty < 4; ++ty)
#pragma unroll
        for (int m = 0; m < 4; ++m) acc[ty][m] = __builtin_amdgcn_mfma_f32_16x16x32_bf16(a[m], wfr[kk][ty], acc[ty][m], 0, 0, 0);
    }
  }
  lds_barrier();
  PTICK(19)
  const int chl = 16 * w + lr, chg1 = blk * 128 + chl;
#pragma unroll
  for (int dir = 0; dir < 2; ++dir) {
    {
      const float ba = prm[dir][0], bx = prm[dir][1];
      const float spl = softplusf_(-prm[dir][2]);
#pragma unroll
      for (int m = 0; m < 4; ++m)
#pragma unroll
        for (int jj = 0; jj < 4; ++jj) {
          const int pos = 16 * m + 4 * lq + jj;
          float r = sigmoidf_(acc[dir * 2][m][jj] + ba);
          float ig = sigmoidf_(acc[dir * 2 + 1][m][jj] + bx);
          float la = -8.f * r * spl;
          float a = __expf(la);
          float bb = __builtin_amdgcn_sqrtf(fmaxf(1.f - a * a, 0.f)) * ig * xcf[pos * LS + chl];
          Aa[pos * LS + chl] = a;
          Bb[pos * LS + chl] = bb;
        }
    }
    lds_barrier();
    PTICK(20)
    {
      float* SA = carry + 256;
      float* SB = carry + 768;
      const int seg = t >> 7, ch = t & 127, chg = blk * 128 + ch;
      const int pbase = dir ? 63 - 16 * seg : 16 * seg;
      const int pstep = dir ? -LS : LS;
      float* ap_ = Aa + pbase * LS + ch;
      float* bp_ = Bb + pbase * LS + ch;
      float av[16], bv[16];
#pragma unroll
      for (int i = 0; i < 16; ++i) { av[i] = ap_[i * pstep]; bv[i] = bp_[i * pstep]; }
      float prod = 1.f, hh = 0.f;
#pragma unroll
      for (int i = 0; i < 16; ++i) { hh = av[i] * hh + bv[i]; prod *= av[i]; av[i] = prod; bv[i] = hh; }
      SA[seg * 128 + ch] = prod;
      SB[seg * 128 + ch] = hh;
      lds_barrier();
      if (pass == 0) {
        if (seg == 0) {
          float pa = 1.f, hb = 0.f;
#pragma unroll
          for (int s2 = 0; s2 < 4; ++s2) { const float a2 = SA[s2 * 128 + ch]; hb = a2 * hb + SB[s2 * 128 + ch]; pa *= a2; }
          AGG[((size_t)(sc * 2 + dir) * 2 + 0) * 1024 + chg] = pa;
          AGG[((size_t)(sc * 2 + dir) * 2 + 1) * 1024 + chg] = hb;
        }
      } else {
        float cin = carry[dir * 128 + ch];
        for (int s2 = 0; s2 < seg; ++s2) cin = SA[s2 * 128 + ch] * cin + SB[s2 * 128 + ch];
        float* hp_ = HF + pbase * LS + ch;
        float hlast = 0.f;
#pragma unroll
        for (int i = 0; i < 16; ++i) {
          const float hv = bv[i] + av[i] * cin;
          if (dir == 0) hp_[i * pstep] = hv; else hp_[i * pstep] += hv;
          hlast = hv;
        }
        if (seg == 3 && sc < 16) {
          if (dir == 0 && cidx == 3) p.out[OUT_SBF + (size_t)(g * 4 + (sc >> 2)) * 1024 + chg] = hlast;
          if (dir == 1 && cidx == 0) p.out[OUT_SBB + (size_t)(g * 4 + (sc >> 2)) * 1024 + chg] = hlast;
        }
      }
    }
    lds_barrier();
  }
  PTICK(21)
  if (pass == 1) {
    us* OCAT = (us*)(p.ws + WS_OCAT);
    const int pp = t >> 3, cg8 = t & 7;
    const int R = grow(g, lru_row(sc, pp));
    const float* hs = HF + pp * LS + cg8 * 16;
    uint4 o0, o1;
    o0.x = pack2(hs[0], hs[1]); o0.y = pack2(hs[2], hs[3]); o0.z = pack2(hs[4], hs[5]); o0.w = pack2(hs[6], hs[7]);
    o1.x = pack2(hs[8], hs[9]); o1.y = pack2(hs[10], hs[11]); o1.z = pack2(hs[12], hs[13]); o1.w = pack2(hs[14], hs[15]);
    us* dst = OCAT + (size_t)R * 2048 + 1024 + blk * 128 + cg8 * 16;
    *(uint4*)dst = o0;
    *(uint4*)(dst + 8) = o1;
  }
  lds_barrier();
}

__device__ void phase_finalize(const Params& p, int g, const us* OF, const us* OB) {
  const int t_ = tid_l();
  const int lane = t_ & 63, wv = t_ >> 6;
  const float* ow = IN(18);
  us* OCAT = (us*)(p.ws + WS_OCAT);
  for (int r = blockIdx.x * 8 + wv; r < GR; r += gridDim.x * 8) {
    const int R = grow(g, r);
    const int e0 = lane * 16;
    float o[16];
    float ss = 0.f;
    {
      const uint4* pa = (const uint4*)(OF + (size_t)r * 1024 + e0);
      const uint4* pb = (const uint4*)(OB + (size_t)r * 1024 + e0);
      const uint4 a0 = pa[0], a1 = pa[1], b0 = pb[0], b1 = pb[1];
      const unsigned wa[8] = {a0.x, a0.y, a0.z, a0.w, a1.x, a1.y, a1.z, a1.w};
      const unsigned wb[8] = {b0.x, b0.y, b0.z, b0.w, b1.x, b1.y, b1.z, b1.w};
#pragma unroll
      for (int i = 0; i < 8; ++i) {
        o[2 * i] = __uint_as_float(wa[i] << 16) + __uint_as_float(wb[i] << 16);
        o[2 * i + 1] = __uint_as_float(wa[i] & 0xffff0000u) + __uint_as_float(wb[i] & 0xffff0000u);
      }
    }
#pragma unroll
    for (int i = 0; i < 16; ++i) ss += o[i] * o[i];
    ss += shfl_lane(ss, lane ^ 1);
    ss += shfl_lane(ss, lane ^ 2);
    ss += shfl_lane(ss, lane ^ 4);
    const float rstd = rsqrtf(ss * (1.f / 128.f) + 1e-6f);
    const int wo = (lane & 7) * 16;
    uint4 o0, o1;
    float y[16];
#pragma unroll
    for (int i = 0; i < 16; ++i) y[i] = o[i] * rstd * ow[wo + i];
    o0.x = pack2(y[0], y[1]); o0.y = pack2(y[2], y[3]); o0.z = pack2(y[4], y[5]); o0.w = pack2(y[6], y[7]);
    o1.x = pack2(y[8], y[9]); o1.y = pack2(y[10], y[11]); o1.z = pack2(y[12], y[13]); o1.w = pack2(y[14], y[15]);
    us* dst = OCAT + (size_t)R * 2048 + e0;
    *(uint4*)dst = o0;
    *(uint4*)(dst + 8) = o1;
  }
}

#define XB_TMO      128
#define XB_XCNT(j)  (256  + 64 * (j))
#define XB_XSUB(j)  (1280 + 64 * (j))
#define XB_XGEN(j)  (2304 + 64 * (j))
#define XB_TOP      3328
#define XB_TOPGEN   3392
#define XCD_BAR_WORDS 3456
#define XB_SPIN_CAP (1u << 18)
#define LAS __attribute__((address_space(3)))

__device__ __forceinline__ unsigned xb_ld(unsigned* p)              { return __hip_atomic_load(p, __ATOMIC_RELAXED, __HIP_MEMORY_SCOPE_AGENT); }
__device__ __forceinline__ unsigned xb_add(unsigned* p, unsigned v) { return __hip_atomic_fetch_add(p, v, __ATOMIC_RELAXED, __HIP_MEMORY_SCOPE_AGENT); }
__device__ __forceinline__ unsigned xb_xcc_id() { return (unsigned)__builtin_amdgcn_s_getreg((3 << 11) | 20) & 0xFu; }
#define XB_SPIN(cond, bar) do { unsigned _sp = 0; while (cond) { __builtin_amdgcn_s_sleep(1); \
    if ((++_sp & 255u) == 0u) { if (xb_ld(&(bar)[XB_TMO])) break; if (_sp > XB_SPIN_CAP) { atomicAdd(&(bar)[XB_TMO], 1u); break; } } } } while (0)

struct XcdBarrier {
    unsigned* bar; unsigned x;
    volatile LAS unsigned* st;
};

__device__ __forceinline__ XcdBarrier xcd_barrier_post(unsigned* bar, volatile LAS unsigned* st) {
    XcdBarrier b; b.bar = bar; b.x = xb_xcc_id(); b.st = st;
    if (threadIdx.x == 0) (void)xb_add(&bar[XB_XCNT(b.x)], 1u);
    return b;
}
__device__ __forceinline__ void xcd_barrier_complete(unsigned* bar, unsigned x, unsigned& nloc, unsigned& nx) {
    const unsigned G = gridDim.x * gridDim.y * gridDim.z;
    unsigned sum, cnt, mine, sp = 0u;
    for (;;) {
        sum = 0u; cnt = 0u; mine = 0u;
#pragma unroll
        for (unsigned j = 0; j < 16; ++j) { const unsigned c = xb_ld(&bar[XB_XCNT(j)]); sum += c; cnt += (c > 0u) ? 1u : 0u; mine = (j == x) ? c : mine; }
        if (sum == G) break;
        __builtin_amdgcn_s_sleep(1);
        if ((++sp & 255u) == 0u) { if (xb_ld(&bar[XB_TMO])) break; if (sp > XB_SPIN_CAP) { atomicAdd(&bar[XB_TMO], 1u); break; } }
    }
    nloc = mine > 0u ? mine : 1u; nx = cnt > 0u ? cnt : 1u;
}

__device__ __forceinline__ void xcd_barrier(const XcdBarrier& b) {
    asm volatile("s_waitcnt vmcnt(0)" ::: "memory");
    __syncthreads();
    if (threadIdx.x == 0) {
        unsigned* bar = b.bar;
        __builtin_amdgcn_s_waitcnt(0);
        unsigned nloc = b.st[0], nx = b.st[1];
        if (nloc == 0u) { xcd_barrier_complete(bar, b.x, nloc, nx); b.st[0] = nloc; b.st[1] = nx; }
        const unsigned old = xb_add(&bar[XB_XSUB(b.x)], 1u);
        const unsigned gen = old / nloc;
        if (old + 1u == (gen + 1u) * nloc) {
            __builtin_amdgcn_fence(__ATOMIC_RELEASE, "agent");
            asm volatile("s_waitcnt vmcnt(0)" ::: "memory");
            const unsigned og = xb_add(&bar[XB_TOP], 1u);
            const unsigned tg = og / nx;
            if (og + 1u == (tg + 1u) * nx) xb_add(&bar[XB_TOPGEN], 1u);
            else XB_SPIN(xb_ld(&bar[XB_TOPGEN]) == tg, bar);
            __builtin_amdgcn_fence(__ATOMIC_ACQUIRE, "agent");
            xb_add(&bar[XB_XGEN(b.x)], 1u);
            asm volatile("s_waitcnt vmcnt(0)" ::: "memory");
        } else {
            XB_SPIN(xb_ld(&bar[XB_XGEN(b.x)]) == gen, bar);
            __builtin_amdgcn_fence(__ATOMIC_ACQUIRE, "agent");
            asm volatile("s_waitcnt vmcnt(0)" ::: "memory");
        }
    }
    __syncthreads();
}


__global__ void __launch_bounds__(512) fwd_megakernel(Params p) {
  cg::grid_group grid = cg::this_grid();
#define XB_WORDS ((volatile LAS unsigned*)((LAS char*)shm + (LDS_BYTES - 16)))
  if (threadIdx.x == 0) { XB_WORDS[0] = 0u; XB_WORDS[1] = 0u; }
  __syncthreads();
  (void)xcd_barrier_post((unsigned*)(p.ws + WS_BAR), XB_WORDS);
#define GRID_BAR()                                                                                 \
  {                                                                                                \
    XcdBarrier xb_;                                                                                \
    xb_.bar = (unsigned*)(p.ws + WS_BAR + zopaque());                                              \
    xb_.x = xb_xcc_id();                                                                           \
    xb_.st = XB_WORDS;                                                                             \
    xcd_barrier(xb_);                                                                              \
  }
#define H_PTR ((bf16*)p.out)
#define OF_PTR ((us*)(p.ws + WS_OF))
#define OB_PTR ((us*)(p.ws + WS_OB))

#ifndef PROBE_MASK
#define PROBE_MASK 0
#endif
  long long tacc = 0;
#if PROBE_MASK
  long long tprev = wall_clock64();
#define TICK(PH)                                              \
  {                                                           \
    long long tn_ = wall_clock64();                           \
    if ((PROBE_MASK >> (PH)) & 1) tacc += tn_ - tprev;        \
    tprev = tn_;                                              \
  }
#define WCLK() wall_clock64()
#else
#define TICK(PH)
#define WCLK() 0ll
#endif
  phase_mod(p);
  phase_weights(p);
  GRID_BAR()
  if (p.ws == nullptr) grid.sync();
  TICK(0)
  phase_h(p, H_PTR);
  GRID_BAR()
  TICK(1)
  for (int ph_ = 0; ph_ <= NG + 1; ++ph_) {
    const int ph = __builtin_amdgcn_readfirstlane(ph_);
    {
      const int b = blockIdx.x;
      const bool seqph = (ph > 0) && (ph <= NG);
      const bool lat = seqph && (gridDim.x >= 128) && (b < 64);
      const int nG = (ph < NG) ? 340 : 0;
      const int nB = (ph == NG) ? 36 * 16 : (ph == NG + 1 ? 44 * 16 : 0);
      const int nL = seqph ? 640 : 0;
      const int nC = seqph ? ((gridDim.x >= 128) ? 256 : 320) : 0;
      const int c0 = (gridDim.x >= 128) ? 64 : 0;
      unsigned* qctr = (unsigned*)(p.ws + WS_BAR) + 3500 + ph;
      volatile LAS unsigned* qword = (volatile LAS unsigned*)((LAS char*)shm + (LDS_BYTES - 32));
      bool first = lat;
      for (;;) {
        int kind, arg;
        if (first) {
          const int xcd_ = b & 7, k_ = b >> 3;
          kind = 2; arg = (xcd_ * 2 + (k_ >> 2)) * 4 + (k_ & 3); first = false;
        }
        else {
          lds_barrier();
          if (threadIdx.x == 0) qword[0] = __hip_atomic_fetch_add(qctr, 1u, __ATOMIC_RELAXED, __HIP_MEMORY_SCOPE_AGENT);
          lds_barrier();
          const int idx = (int)qword[0];
          if (idx >= nG + nB + nL + nC) break;
          if (idx < nG) { kind = 0; arg = idx; }
          else if (idx < nG + nB) { kind = 3; arg = idx - nG; }
          else if (idx < nG + nB + nL) { kind = 1; arg = idx - nG - nB; }
          else { kind = 2; arg = c0 + idx - nG - nB - nL; }
        }
        if (kind == 0) phase_gemm1a(p, H_PTR, ph, arg, 1 << 20);
        else if (kind == 3) phase_gemm1b(p, H_PTR, arg, 1 << 20, ph == NG ? 0 : 1);
        else if (kind == 1) lru_item(p, ph - 1, arg, 1, tacc);
        else {
          long long ta_ = WCLK();
          gdn_seq_item(p, ph - 1, arg, OF_PTR, OB_PTR);
          long long tb_ = WCLK();
          if (((PROBE_MASK >> 12) & 1) && arg < 64) tacc += tb_ - ta_;
        }
      }
    }
    GRID_BAR()
    TICK(4)
    if (ph <= NG) {
      const int g = ph;
      if (g > 0) phase_finalize(p, g - 1, OF_PTR, OB_PTR);
      if (ph < NG) {
        for (int it = blockIdx.x; it < 1280; it += gridDim.x) {
          long long ta_ = WCLK();
          if (it < 640) gdn_prep_item(p, it, tacc);
          else lru_item(p, g, it - 640, 0, tacc);
          long long tb_ = WCLK();
          if ((PROBE_MASK >> (it < 640 ? 10 : 11)) & 1) tacc += tb_ - ta_;
        }
      }
      GRID_BAR()
      TICK(3)
    }
  }
  {
    unsigned* qctr = (unsigned*)(p.ws + WS_BAR) + 3510;
    unsigned* rbcnt = (unsigned*)(p.ws + WS_BAR) + 3520;
    volatile LAS unsigned* qword = (volatile LAS unsigned*)((LAS char*)shm + (LDS_BYTES - 32));
    unsigned* tflag = (unsigned*)(p.ws + WS_BAR) + 3600;
    for (;;) {
      lds_barrier();
      if (threadIdx.x == 0) qword[0] = __hip_atomic_fetch_add(qctr, 1u, __ATOMIC_RELAXED, __HIP_MEMORY_SCOPE_AGENT);
      lds_barrier();
      const int idx = (int)qword[0];
      if (idx >= 960) break;
      if (idx < 640) {
        const int half = idx >= 320 ? 1 : 0;
        const int tile = idx - half * 320;
        if (half) {
          if (threadIdx.x == 0) {
            while (__hip_atomic_load(tflag + tile, __ATOMIC_RELAXED, __HIP_MEMORY_SCOPE_AGENT) < 1u) __builtin_amdgcn_s_sleep(2);
            __builtin_amdgcn_fence(__ATOMIC_ACQUIRE, "agent");
            asm volatile("s_waitcnt vmcnt(0)" ::: "memory");
          }
          lds_barrier();
        }
        phase_gemm3(p, tile, half);
        asm volatile("s_waitcnt vmcnt(0)" ::: "memory");
        lds_barrier();
        if (threadIdx.x == 0)
          __hip_atomic_fetch_add(half ? rbcnt + (tile >> 2) : tflag + tile, 1u, __ATOMIC_RELAXED, __HIP_MEMORY_SCOPE_AGENT);
      } else {
        const int j = idx - 640;
        if (threadIdx.x == 0) {
          while (__hip_atomic_load(rbcnt + (j >> 2), __ATOMIC_RELAXED, __HIP_MEMORY_SCOPE_AGENT) < 4u) __builtin_amdgcn_s_sleep(2);
          __builtin_amdgcn_fence(__ATOMIC_ACQUIRE, "agent");
          asm volatile("s_waitcnt vmcnt(0)" ::: "memory");
        }
        lds_barrier();
        phase_gemm4(p, j, 1 << 20);
      }
    }
  }
  GRID_BAR()
  TICK(8)
#ifdef EXTRA_SYNCS
  for (int i = 0; i < EXTRA_SYNCS; ++i) GRID_BAR()
#endif
  phase_final(p);
  TICK(9)
#if PROBE_MASK
  if (blockIdx.x == 0) {
    long long s0 = wall_clock64();
    while (wall_clock64() - s0 < tacc) {}
  }
#endif
}

extern "C" void kernel_launch(void* const* d_in, const int* in_sizes, int n_in, void* d_out, int out_size, void* d_ws,
                              size_t ws_size, hipStream_t stream) {
  static int grid_blocks = 0;
  if (grid_blocks == 0) {
    int dev = 0, cus = 0, per_cu = 0;
    hipGetDevice(&dev);
    hipDeviceGetAttribute(&cus, hipDeviceAttributeMultiprocessorCount, dev);
    if (hipFuncSetAttribute((const void*)fwd_megakernel, hipFuncAttributeMaxDynamicSharedMemorySize, LDS_BYTES) != hipSuccess)
      fprintf(stderr, "hipFuncSetAttribute failed\n");
    hipOccupancyMaxActiveBlocksPerMultiprocessor(&per_cu, (const void*)fwd_megakernel, 512, LDS_BYTES);
    if (per_cu < 1) { fprintf(stderr, "occupancy query says %d blocks/CU\n", per_cu); per_cu = 1; }
    if (per_cu > 1) per_cu = 1;
    grid_blocks = cus * per_cu;
    if (ws_size < WS_END2) fprintf(stderr, "workspace too small: %zu < %zu\n", ws_size, (size_t)WS_END);
  }
  Params p{};
  for (int i = 0; i < 37; ++i) p.in[i] = (const float*)d_in[i];
  p.out = (float*)d_out;
  p.ws = (char*)d_ws;
  if (hipMemsetAsync((char*)d_ws + WS_BAR, 0, 16384, stream) != hipSuccess) fprintf(stderr, "memset of barrier words failed\n");
  void* args[] = {&p};
  hipError_t e = hipLaunchCooperativeKernel((const void*)fwd_megakernel, dim3(grid_blocks), dim3(512), args, LDS_BYTES, stream);
  if (e != hipSuccess) fprintf(stderr, "cooperative launch failed: %s (grid %d)\n", hipGetErrorString(e), grid_blocks);
}
```

```cpp
#include <hip/hip_runtime.h>
#include <hip/hip_bf16.h>
#include <hip/hip_cooperative_groups.h>
#include <cstdio>
#include <cstdint>
#include <type_traits>
namespace cg = cooperative_groups;

using bf16 = __hip_bfloat16;
using bf16x8 = __attribute__((ext_vector_type(8))) short;
using f32x4 = __attribute__((ext_vector_type(4))) float;
typedef unsigned short us;

constexpr int DM = 1024;
constexpr int NTOK = 20480;
constexpr int NG = 4;
constexpr int GR = 5120;
constexpr int NA = 4352;
constexpr int NB1 = 4096;
constexpr int OUT_SAF = 20971520, OUT_SAB = 23068672, OUT_SBF = 25165824, OUT_SBB = 25182208;

constexpr size_t WS_WA = 0;
constexpr size_t WS_WB = WS_WA + (size_t)NA * 1024 * 2;
constexpr size_t WS_WPA = WS_WB + (size_t)NB1 * 1024 * 2;
constexpr size_t WS_WPB = WS_WPA + 4194304;
constexpr size_t WS_WOUT = WS_WPB + 4194304;
constexpr size_t WS_WL = WS_WOUT + 4194304;
constexpr size_t WS_MOD = WS_WL + 1048576;
constexpr size_t WS_OCAT = WS_MOD + 65536;
constexpr size_t WS_BIG = WS_OCAT + (size_t)NTOK * 2048 * 2;
constexpr size_t WS_QKV = WS_BIG;
constexpr size_t WS_XB = WS_QKV + (size_t)GR * 3072 * 2;
constexpr size_t WS_GC = WS_XB + (size_t)GR * 1024 * 2;
constexpr size_t WS_AGG = WS_GC + (size_t)GR * 32 * 4;
constexpr size_t WS_Q = WS_AGG + (size_t)80 * 4 * 1024 * 4;
constexpr size_t WS_KT = WS_Q + (size_t)640 * 8192 * 2;
constexpr size_t WS_WN = WS_KT + (size_t)640 * 8192 * 2;
constexpr size_t WS_U = WS_WN + (size_t)1280 * 8192 * 2;
constexpr size_t WS_QKM = WS_U + (size_t)1280 * 8192 * 2;
constexpr size_t WS_EG = WS_QKM + (size_t)1280 * 4096 * 2;
constexpr size_t WS_ES = WS_EG + (size_t)1280 * 64 * 4;
constexpr size_t WS_DL = WS_ES + (size_t)1280 * 64 * 4;
constexpr size_t WS_GEND = WS_DL + 8192;
constexpr size_t WS_GATE = WS_BIG;
constexpr size_t WS_END = WS_GATE + (size_t)NTOK * 2048 * 2;
static_assert(WS_GEND <= 268435456ull, "group region too large");
constexpr size_t WS_OF = (WS_END > WS_GEND ? WS_END : WS_GEND);
constexpr size_t WS_OB = WS_OF + (size_t)GR * 1024 * 2;
constexpr size_t WS_XB2 = WS_OB + (size_t)GR * 1024 * 2;
constexpr size_t WS_BAR = WS_XB2 + (size_t)GR * 1024 * 2;
constexpr size_t WS_END2 = WS_BAR + 16384;
static_assert(WS_END2 <= 268435456ull, "workspace too large");

#ifndef PROBE_MASK
#define PROBE_MASK 0
#endif
constexpr int LDS_BYTES = 147456;

struct Params {
  const float* in[37];
  float* out;
  char* ws;
};

extern __shared__ __attribute__((aligned(16))) bf16 shm[];

typedef __bf16 hwbf2 __attribute__((ext_vector_type(2)));
typedef float hwf2 __attribute__((ext_vector_type(2)));
__device__ __forceinline__ us f2bf(float f) { return __builtin_bit_cast(us, (__bf16)f); }
__device__ __forceinline__ float bf2f(us b) { return __uint_as_float(((unsigned)b) << 16); }
__device__ __forceinline__ float frcp_(float x) { return __builtin_amdgcn_rcpf(x); }
__device__ __forceinline__ float sigmoidf_(float x) { return frcp_(1.f + __expf(-x)); }
__device__ __forceinline__ float siluf_(float x) { return x * frcp_(1.f + __expf(-x)); }
__device__ __forceinline__ float softplusf_(float x) { return x > 20.f ? x : log1pf(__expf(x)); }
__device__ __forceinline__ unsigned pack2(float a, float b) {
  hwf2 v = {a, b};
  return __builtin_bit_cast(unsigned, __builtin_convertvector(v, hwbf2));
}

__device__ __forceinline__ void lds_barrier() {
  asm volatile("s_waitcnt lgkmcnt(0)" ::: "memory");
  __builtin_amdgcn_s_barrier();
  asm volatile("" ::: "memory");
}

__device__ __forceinline__ int zopaque() {
  int z;
  asm volatile("s_mov_b32 %0, 0" : "=s"(z));
  return z;
}
#define IN(K) (p.in[(K) + zopaque()])

__device__ __forceinline__ int tid_l() {
  int t = threadIdx.x;
  asm volatile("" : "+v"(t));
  return t;
}

__device__ __forceinline__ float shfl_lane(float v, int src_lane) {
  return __int_as_float(__builtin_amdgcn_ds_bpermute(src_lane << 2, __float_as_int(v)));
}

__device__ __forceinline__ int grow(int g, int r) {
  return r < 1024 ? g * 1024 + r : 4096 + g * 4096 + (r - 1024);
}
__device__ __forceinline__ const float* xrow(const Params& p, int R) {
  return R < 4096 ? IN(0) + (size_t)R * 1024 : IN(1) + (size_t)(R - 4096) * 1024;
}
__device__ __forceinline__ int modidx(int R) { return R < 4096 ? 0 : 1 + ((R - 4096) >> 12); }

constexpr int BK = 64, HALF = 128, HT = HALF * BK;
__device__ __forceinline__ int lds_byte(int r, int c) {
  int st = (r >> 4) * 2 + (c >> 5), rr = r & 15, cc = c & 31, ob = rr * 64 + cc * 2;
  return st * 1024 + (ob ^ (((ob >> 9) & 1) << 5));
}
__device__ __forceinline__ void stage_rc(int b, int& R, int& C) {
  int st = b / 1024, sb = b % 1024, swz = sb ^ (((sb >> 9) & 1) << 5);
  R = (st >> 1) * 16 + swz / 64;
  C = (st & 1) * 32 + (swz % 64) / 2;
}

__device__ __forceinline__ void gemm_tile(const bf16* __restrict__ A, int lda, const bf16* __restrict__ Bt, int ldb, int K,
                                          f32x4 (&acc)[2][2][4][2]) {
#define SA(b, h) (shm + ((b)*2 + (h)) * HT)
#define SB(b, h) (shm + (4 + (b)*2 + (h)) * HT)
#define STAGE(P, BASE, LD, br, kt)                                                                       \
  do {                                                                                                   \
    const bf16* _gb = (BASE) + ((long)(br) * (LD) + (long)(kt)*BK);                                      \
    const int _o0 = ((LD) == lda) ? oa0 : ob0, _o1 = ((LD) == lda) ? oa1 : ob1;                          \
    __builtin_amdgcn_global_load_lds((const unsigned*)(_gb + _o0), (unsigned*)((char*)(P) + lb0), 16, 0, 0); \
    __builtin_amdgcn_global_load_lds((const unsigned*)(_gb + _o1), (unsigned*)((char*)(P) + lb0 + 8192), 16, 0, 0); \
  } while (0)
#define LDA(dst, b, h)                                                                                   \
  _Pragma("unroll") for (int m = 0; m < 4; ++m)                                                          \
    _Pragma("unroll") for (int k = 0; k < 2; ++k)                                                        \
  dst[m][k] = *reinterpret_cast<const bf16x8*>((char*)shm + (((b)*2 + (h)) * 16384 + m * 2048 + k * 1024) + baseA)
#define LDB(dst, b, h)                                                                                   \
  _Pragma("unroll") for (int n = 0; n < 2; ++n)                                                          \
    _Pragma("unroll") for (int k = 0; k < 2; ++k)                                                        \
  dst[n][k] = *reinterpret_cast<const bf16x8*>((char*)shm + ((4 + (b)*2 + (h)) * 16384 + n * 2048 + k * 1024) + baseB)
#define MMA(ai, bj, At, Bt_)                                                                             \
  do {                                                                                                   \
    __builtin_amdgcn_s_setprio(1);                                                                       \
    _Pragma("unroll") for (int m = 0; m < 4; ++m)                                                        \
      _Pragma("unroll") for (int n = 0; n < 2; ++n)                                                      \
        _Pragma("unroll") for (int k = 0; k < 2; ++k)                                                    \
          acc[ai][bj][m][n] = __builtin_amdgcn_mfma_f32_16x16x32_bf16(At[m][k], Bt_[n][k], acc[ai][bj][m][n], 0, 0, 0); \
    __builtin_amdgcn_s_setprio(0);                                                                       \
  } while (0)
#define WAIT_V(n) asm volatile("s_waitcnt vmcnt(" #n ")" ::: "memory")
#define WAIT_L(n) asm volatile("s_waitcnt lgkmcnt(" #n ")" ::: "memory")
#define BAR __builtin_amdgcn_s_barrier()
#define SCHED __builtin_amdgcn_sched_barrier(0)
  const int tid = tid_l();
  const int wid = tid >> 6, lane = tid & 63, wr = wid >> 2, wc = wid & 3, fr = lane & 15, fq = lane >> 4;
  bf16x8 At[4][2], B0[2][2], B1[2][2];
  const int nt = K / BK;
  const int ob_ = fr * 64 + fq * 16;
  const int swz_ = ob_ ^ (((ob_ >> 9) & 1) << 5);
  const int baseA = wr * 8192 + swz_, baseB = wc * 4096 + swz_;
  const int lb0 = tid * 16;
  int r_0, c_0, r_1, c_1;
  stage_rc(lb0, r_0, c_0);
  stage_rc(lb0 + 8192, r_1, c_1);
  const int oa0 = r_0 * lda + c_0, oa1 = r_1 * lda + c_1, ob0 = r_0 * ldb + c_0, ob1 = r_1 * ldb + c_1;
  const int brow = 0, bcol = 0;
  STAGE(SB(0, 0), Bt, ldb, bcol, 0);
  STAGE(SA(0, 0), A, lda, brow, 0);
  STAGE(SB(0, 1), Bt, ldb, bcol + HALF, 0);
  STAGE(SA(0, 1), A, lda, brow + HALF, 0);
  if (wr == 1) BAR;
  WAIT_V(4);
  BAR;
  STAGE(SB(1, 0), Bt, ldb, bcol, 1);
  STAGE(SA(1, 0), A, lda, brow, 1);
  STAGE(SB(1, 1), Bt, ldb, bcol + HALF, 1);
  WAIT_V(6);
  BAR;
  for (int t = 0; t < nt - 2; t += 2) {
    LDB(B0, 0, 0); SCHED; LDA(At, 0, 0); STAGE(SA(1, 1), A, lda, brow + HALF, t + 1);
    WAIT_L(8); BAR; WAIT_L(0); MMA(0, 0, At, B0); BAR; SCHED;
    LDB(B1, 0, 1); STAGE(SB(0, 0), Bt, ldb, bcol, t + 2);
    BAR; WAIT_L(0); MMA(0, 1, At, B1); BAR;
    LDA(At, 0, 1); STAGE(SA(0, 0), A, lda, brow, t + 2);
    BAR; WAIT_L(0); MMA(1, 0, At, B0); BAR; SCHED;
    STAGE(SB(0, 1), Bt, ldb, bcol + HALF, t + 2);
    WAIT_V(6); BAR; MMA(1, 1, At, B1); BAR;
    LDB(B0, 1, 0); SCHED; LDA(At, 1, 0); STAGE(SA(0, 1), A, lda, brow + HALF, t + 2);
    WAIT_L(8); BAR; WAIT_L(0); MMA(0, 0, At, B0); BAR; SCHED;
    LDB(B1, 1, 1); STAGE(SB(1, 0), Bt, ldb, bcol, t + 3);
    BAR; WAIT_L(0); MMA(0, 1, At, B1); BAR;
    LDA(At, 1, 1); STAGE(SA(1, 0), A, lda, brow, t + 3);
    BAR; WAIT_L(0); MMA(1, 0, At, B0); BAR; SCHED;
    STAGE(SB(1, 1), Bt, ldb, bcol + HALF, t + 3);
    WAIT_V(6); BAR; MMA(1, 1, At, B1); BAR;
  }
  {
    LDB(B0, 0, 0); LDA(At, 0, 0); STAGE(SA(1, 1), A, lda, brow + HALF, nt - 1);
    BAR; WAIT_L(0); MMA(0, 0, At, B0); BAR;
    LDB(B1, 0, 1); BAR; WAIT_L(0); MMA(0, 1, At, B1); BAR;
    LDA(At, 0, 1); WAIT_V(4); BAR; WAIT_L(0); MMA(1, 0, At, B0); MMA(1, 1, At, B1); BAR;
  }
  {
    LDB(B0, 1, 0); LDA(At, 1, 0); WAIT_V(2); BAR; WAIT_L(0); MMA(0, 0, At, B0); BAR;
    LDB(B1, 1, 1); WAIT_V(0); BAR; WAIT_L(0); MMA(0, 1, At, B1); BAR;
    LDA(At, 1, 1); BAR; WAIT_L(0); MMA(1, 0, At, B0); MMA(1, 1, At, B1); BAR;
  }
  if (wr == 0) BAR;
}

template <class F>
__device__ __forceinline__ void epilogue(f32x4 (&acc)[2][2][4][2], F f) {
  float* tile = (float*)shm;
  int tid = threadIdx.x;
  asm volatile("" : "+v"(tid));
  const int wid = tid >> 6, lane = tid & 63, wr = wid >> 2, wc = wid & 3, fr = lane & 15, fq = lane >> 4;
#pragma unroll
  for (int ai = 0; ai < 2; ++ai) {
    lds_barrier();
#pragma unroll
    for (int bj = 0; bj < 2; ++bj)
#pragma unroll
      for (int m = 0; m < 4; ++m)
#pragma unroll
        for (int n = 0; n < 2; ++n)
#pragma unroll
          for (int j = 0; j < 4; ++j)
            tile[(wr * 64 + m * 16 + fq * 4 + j) * 260 + bj * 128 + wc * 32 + n * 16 + fr] = acc[ai][bj][m][n][j];
    lds_barrier();
#pragma unroll 4
    for (int it = 0; it < 16; ++it) {
      const int idx = it * 512 + tid;
      const int row = idx >> 6, c4 = (idx & 63) * 4;
      const float4 v = *(const float4*)(tile + row * 260 + c4);
      f(ai * 128 + row, c4, v);
    }
  }
  lds_barrier();
}

__device__ __forceinline__ void zero_acc(f32x4 (&acc)[2][2][4][2]) {
#pragma unroll
  for (int a = 0; a < 2; ++a)
#pragma unroll
    for (int b = 0; b < 2; ++b)
#pragma unroll
      for (int m = 0; m < 4; ++m)
#pragma unroll
        for (int n = 0; n < 2; ++n) acc[a][b][m][n] = f32x4{0.f, 0.f, 0.f, 0.f};
}

__device__ void phase_mod(const Params& p) {
  float* sc = (float*)shm;
  float* part = sc + 5 * 1024;
  const int t = tid_l();
  for (int i = t; i < 5 * 1024; i += 512) {
    int v = i >> 10, k = i & 1023;
    float c = v == 0 ? IN(7)[k] : IN(6)[(v - 1) * 1024 + k];
    sc[i] = siluf_(c);
  }
  lds_barrier();
  const int cc = t & 15, kk = t >> 4;
  for (int cgp = blockIdx.x; cgp < 256; cgp += gridDim.x) {
    const int col = cgp * 12 + cc;
    float a[5] = {0.f, 0.f, 0.f, 0.f, 0.f};
    if (cc < 12) {
      const float* w = IN(9);
      for (int k = kk; k < 1024; k += 32) {
        float wv = w[(size_t)k * 3072 + col];
#pragma unroll
        for (int v = 0; v < 5; ++v) a[v] += sc[v * 1024 + k] * wv;
      }
    }
#pragma unroll
    for (int v = 0; v < 5; ++v) part[(kk * 5 + v) * 16 + cc] = a[v];
    lds_barrier();
    if (t < 80) {
      int v = t >> 4, c2 = t & 15;
      int col2 = cgp * 12 + c2;
      if (c2 < 12) {
        float s = 0.f;
        for (int k2 = 0; k2 < 32; ++k2) s += part[(k2 * 5 + v) * 16 + c2];
        ((float*)(p.ws + WS_MOD))[v * 3072 + col2] = s + IN(10)[col2];
      }
    }
    lds_barrier();
  }
}

__device__ void tr_tile(const float* __restrict__ src, int ld_src, int col0, int nN, bf16* __restrict__ dst, int ld_dst,
                        int kt, int ntile) {
  float* tile = (float*)shm;
  const int t = tid_l();
  const int k0 = kt * 64, n0 = ntile * 64;
  {
    const int n4 = (t & 15) * 4;
    for (int kk = t >> 4; kk < 64; kk += 32) {
      float4 v = make_float4(0.f, 0.f, 0.f, 0.f);
      if (n0 + n4 < nN) v = *reinterpret_cast<const float4*>(src + (size_t)(k0 + kk) * ld_src + col0 + n0 + n4);
      tile[kk * 65 + n4 + 0] = v.x;
      tile[kk * 65 + n4 + 1] = v.y;
      tile[kk * 65 + n4 + 2] = v.z;
      tile[kk * 65 + n4 + 3] = v.w;
    }
  }
  lds_barrier();
  {
    const int n = t >> 3, k8 = (t & 7) * 8;
    if (n0 + n < nN) {
      uint4 o;
      o.x = pack2(tile[(k8 + 0) * 65 + n], tile[(k8 + 1) * 65 + n]);
      o.y = pack2(tile[(k8 + 2) * 65 + n], tile[(k8 + 3) * 65 + n]);
      o.z = pack2(tile[(k8 + 4) * 65 + n], tile[(k8 + 5) * 65 + n]);
      o.w = pack2(tile[(k8 + 6) * 65 + n], tile[(k8 + 7) * 65 + n]);
      *reinterpret_cast<uint4*>(dst + (size_t)(n0 + n) * ld_dst + k0 + k8) = o;
    }
  }
  lds_barrier();
}

__device__ void phase_weights(const Params& p) {
  bf16* WA = (bf16*)(p.ws + WS_WA);
  bf16* WB = (bf16*)(p.ws + WS_WB);
  bf16* WPA = (bf16*)(p.ws + WS_WPA);
  bf16* WPB = (bf16*)(p.ws + WS_WPB);
  bf16* WOUT = (bf16*)(p.ws + WS_WOUT);
  bf16* WL = (bf16*)(p.ws + WS_WL);
  const int total = 768 + 256 + 16 + 256 + 256 + 512 + 256 + 256 + 256 + 128;
  for (int T = blockIdx.x; T < total; T += gridDim.x) {
    int x = T;
    if (x < 768) { tr_tile(IN(11), 6176, 0, 3072, WA, 1024, x & 15, x >> 4); continue; }
    x -= 768;
    if (x < 256) { tr_tile(IN(11), 6176, 4096, 1024, WA + (size_t)3072 * 1024, 1024, x & 15, x >> 4); continue; }
    x -= 256;
    if (x < 16) { tr_tile(IN(11), 6176, 6144, 32, WA + (size_t)4096 * 1024, 1024, x & 15, 0); continue; }
    x -= 16;
    if (x < 256) { tr_tile(IN(11), 6176, 3072, 1024, WB, 1024, x & 15, x >> 4); continue; }
    x -= 256;
    if (x < 256) { tr_tile(IN(11), 6176, 5120, 1024, WB + (size_t)1024 * 1024, 1024, x & 15, x >> 4); continue; }
    x -= 256;
    if (x < 512) { tr_tile(IN(33), 2048, 0, 2048, WB + (size_t)2048 * 1024, 1024, x & 15, x >> 4); continue; }
    x -= 512;
    if (x < 256) { tr_tile(IN(31), 1024, 0, 1024, WPA, 2048, x & 15, x >> 4); continue; }
    x -= 256;
    if (x < 256) { tr_tile(IN(32), 1024, 0, 1024, WPB, 2048, x & 15, x >> 4); continue; }
    x -= 256;
    if (x < 256) {
      tr_tile(IN(35), 1024, 0, 1024, WOUT, 2048, x & 15, x >> 4);
      tr_tile(IN(35), 1024, 0, 1024, WOUT + 1024, 2048, x & 15, x >> 4);
      continue;
    }
    x -= 256;
    {
      int sub = x >> 2, tt = x & 3;
      int type = sub >> 3, blk = sub & 7;
      const int widx[4] = {21, 23, 26, 28};
      const float* src = IN(type == 0 ? 21 : type == 1 ? 23 : type == 2 ? 26 : 28) + (size_t)blk * 128 * 128;
      (void)widx;
      tr_tile(src, 128, 0, 128, WL + ((size_t)blk * 512 + type * 128) * 128, 128, tt & 1, tt >> 1);
    }
  }
  {
    uint4 z = make_uint4(0, 0, 0, 0);
    uint4* dst = (uint4*)(WA + (size_t)4128 * 1024);
    const int n16 = 224 * 1024 * 2 / 16;
    for (int i = blockIdx.x * 512 + tid_l(); i < n16; i += gridDim.x * 512) dst[i] = z;
  }
}

__device__ void phase_h(const Params& p, bf16* H) {
  const int t_ = tid_l();
  const int lane = t_ & 63, wv = t_ >> 6;
  const float* nw = IN(8);
  const float* mod = (const float*)(p.ws + WS_MOD);
  auto process = [&](int R, const float4 (&v)[4]) {
    float ss = 0.f;
#pragma unroll
    for (int i = 0; i < 4; ++i) ss += v[i].x * v[i].x + v[i].y * v[i].y + v[i].z * v[i].z + v[i].w * v[i].w;
    for (int o = 32; o > 0; o >>= 1) ss += shfl_lane(ss, lane ^ o);
    const float rstd = rsqrtf(ss * (1.f / 1024.f) + 1e-6f);
    const float* md = mod + modidx(R) * 3072;
#pragma unroll
    for (int i = 0; i < 4; ++i) {
      const int c = (lane + 64 * i) * 4;
      float4 w4 = *(const float4*)(nw + c);
      float4 sh = *(const float4*)(md + c);
      float4 scl = *(const float4*)(md + 1024 + c);
      float h0 = v[i].x * rstd * w4.x * (1.f + scl.x) + sh.x;
      float h1 = v[i].y * rstd * w4.y * (1.f + scl.y) + sh.y;
      float h2 = v[i].z * rstd * w4.z * (1.f + scl.z) + sh.z;
      float h3 = v[i].w * rstd * w4.w * (1.f + scl.w) + sh.w;
      uint2 o;
      o.x = pack2(h0, h1);
      o.y = pack2(h2, h3);
      *(uint2*)(H + (size_t)R * 1024 + c) = o;
    }
  };
  const int stride = gridDim.x * 8;
  for (int R = blockIdx.x * 8 + wv; R < NTOK; R += 2 * stride) {
    const int R2 = R + stride;
    const bool has2 = R2 < NTOK;
    const float4* xa = (const float4*)xrow(p, R);
    const float4* xb2 = (const float4*)xrow(p, has2 ? R2 : R);
    float4 v[4], u[4];
#pragma unroll
    for (int i = 0; i < 4; ++i) v[i] = xa[lane + 64 * i];
#pragma unroll
    for (int i = 0; i < 4; ++i) u[i] = xb2[lane + 64 * i];
    process(R, v);
    if (has2) process(R2, u);
  }
}

__device__ __forceinline__ uint2 pack4(float a, float b, float c, float d) {
  uint2 o;
  o.x = pack2(a, b);
  o.y = pack2(c, d);
  return o;
}

__device__ void phase_gemm1a(const Params& p, const bf16* H, int g, int first, int stride) {
  const bf16* WA = (const bf16*)(p.ws + WS_WA);
  us* QKV = (us*)(p.ws + WS_QKV);
  us* XB = (us*)(p.ws + ((g & 1) ? WS_XB2 : WS_XB));
  float* GC = (float*)(p.ws + WS_GC);
  for (int T = first; T < 20 * 17; T += stride) {
    const int tm = T % 20, tn = T / 20;
    const int r0 = tm * 256, R0 = grow(g, r0);
    f32x4 acc[2][2][4][2];
    zero_acc(acc);
    gemm_tile(H + (size_t)R0 * 1024, 1024, WA + (size_t)tn * 256 * 1024, 1024, 1024, acc);
    if (tn < 12) {
      epilogue(acc, [&](int row, int c4, float4 v) {
        *(uint2*)(QKV + (size_t)(r0 + row) * 3072 + tn * 256 + c4) = pack4(v.x, v.y, v.z, v.w);
      });
    } else if (tn < 16) {
      epilogue(acc, [&](int row, int c4, float4 v) {
        *(uint2*)(XB + (size_t)(r0 + row) * 1024 + (tn - 12) * 256 + c4) = pack4(v.x, v.y, v.z, v.w);
      });
    } else {
      epilogue(acc, [&](int row, int c4, float4 v) {
        if (c4 < 32) *(float4*)(GC + (size_t)(r0 + row) * 32 + c4) = v;
      });
    }
  }
}

__device__ void phase_gemm1b(const Params& p, const bf16* H, int first, int stride, int mode) {
  const bf16* WB = (const bf16*)(p.ws + WS_WB);
  us* OCAT = (us*)(p.ws + WS_OCAT);
  us* GATE = (us*)(p.ws + WS_GATE);
  const float* bg = IN(34);
  const int ntile = mode == 0 ? 36 * 16 : 44 * 16;
  for (int T = first; T < ntile; T += stride) {
    const int tmi = T >> 4, tn = T & 15;
    const int tm = mode == 0 ? (tmi < 12 ? tmi : tmi + 4) : (tmi < 4 ? 12 + tmi : 36 + tmi);
    const int R0 = tm * 256;
    f32x4 acc[2][2][4][2];
    zero_acc(acc);
    gemm_tile(H + (size_t)R0 * 1024, 1024, WB + (size_t)tn * 256 * 1024, 1024, 1024, acc);
    epilogue(acc, [&](int row, int c4, float4 v) {
      if (tn < 8) {
        uint2* ptr = (uint2*)(OCAT + (size_t)(R0 + row) * 2048 + tn * 256 + c4);
        const uint2 o = *ptr;
        *ptr = pack4(__uint_as_float(o.x << 16) * siluf_(v.x), __uint_as_float(o.x & 0xffff0000u) * siluf_(v.y),
                     __uint_as_float(o.y << 16) * siluf_(v.z), __uint_as_float(o.y & 0xffff0000u) * siluf_(v.w));
      } else {
        const int gc = (tn - 8) * 256 + c4;
        const float4 b4 = *(const float4*)(bg + gc);
        *(uint2*)(GATE + (size_t)(R0 + row) * 2048 + gc) =
            pack4(sigmoidf_(v.x + b4.x), sigmoidf_(v.y + b4.y), sigmoidf_(v.z + b4.z), sigmoidf_(v.w + b4.w));
      }
    });
  }
}

__device__ void phase_gemm3(const Params& p, int T, int half) {
  const bf16* OCAT = (const bf16*)(p.ws + WS_OCAT);
  const bf16* WPA = (const bf16*)(p.ws + WS_WPA);
  const bf16* WPB = (const bf16*)(p.ws + WS_WPB);
  us* GATE = (us*)(p.ws + WS_GATE);
  {
    const int tm = T >> 2, tn = T & 3;
    const int R0 = tm * 256;
    {
      f32x4 acc[2][2][4][2];
      zero_acc(acc);
      const bf16* A = OCAT + (size_t)R0 * 2048 + half * 1024;
      const bf16* Bt = (half ? WPB : WPA) + (size_t)tn * 256 * 2048;
      gemm_tile(A, 2048, Bt, 2048, 1024, acc);
      epilogue(acc, [&](int row, int c4, float4 v) {
        us* base = GATE + (size_t)(R0 + row) * 2048 + tn * 256 + c4;
        const uint2 g = *(const uint2*)(base + half * 1024);
        float r0 = __uint_as_float(g.x << 16) * v.x, r1 = __uint_as_float(g.x & 0xffff0000u) * v.y;
        float r2 = __uint_as_float(g.y << 16) * v.z, r3 = __uint_as_float(g.y & 0xffff0000u) * v.w;
        if (half) {
          const uint2 m = *(const uint2*)base;
          r0 += __uint_as_float(m.x << 16); r1 += __uint_as_float(m.x & 0xffff0000u);
          r2 += __uint_as_float(m.y << 16); r3 += __uint_as_float(m.y & 0xffff0000u);
        }
        const uint2 pk = pack4(r0, r1, r2, r3);
        __hip_atomic_store((unsigned long long*)base, ((unsigned long long)pk.y << 32) | pk.x, __ATOMIC_RELAXED, __HIP_MEMORY_SCOPE_AGENT);
      });
    }
  }
}

__device__ void phase_gemm4(const Params& p, int first, int stride) {
  const bf16* TT = (const bf16*)(p.ws + WS_GATE);
  const bf16* WOUT2 = (const bf16*)(p.ws + WS_WOUT);
  const float* mod = (const float*)(p.ws + WS_MOD);
  for (int T = first; T < 80 * 4; T += stride) {
    const int tm = T >> 2, tn = T & 3;
    const int R0 = tm * 256, c0 = tn * 256;
    f32x4 acc[2][2][4][2];
    zero_acc(acc);
    gemm_tile(TT + (size_t)R0 * 2048, 2048, WOUT2 + (size_t)c0 * 2048, 2048, 1024, acc);
    const float* md = mod + modidx(R0) * 3072 + 2048;
    const float* xr = xrow(p, R0);
    epilogue(acc, [&](int row, int c4, float4 v) {
      const int c = c0 + c4;
      const float4 xv = *(const float4*)(xr + (size_t)row * 1024 + c);
      const float4 m4 = *(const float4*)(md + c);
      float4 o;
      o.x = xv.x + m4.x * v.x;
      o.y = xv.y + m4.y * v.y;
      o.z = xv.z + m4.z * v.z;
      o.w = xv.w + m4.w * v.w;
      *(float4*)(p.out + (size_t)(R0 + row) * 1024 + c) = o;
    });
  }
}

__device__ void phase_final(const Params& p) {
  const int t_ = tid_l();
  const int lane = t_ & 63, wv = t_ >> 6;
  const float* fw = IN(36);
  auto process = [&](int R, const float4 (&v)[4]) {
    float4* x4 = (float4*)(p.out + (size_t)R * 1024);
    float ss = 0.f;
#pragma unroll
    for (int i = 0; i < 4; ++i) ss += v[i].x * v[i].x + v[i].y * v[i].y + v[i].z * v[i].z + v[i].w * v[i].w;
    for (int o = 32; o > 0; o >>= 1) ss += shfl_lane(ss, lane ^ o);
    const float rstd = rsqrtf(ss * (1.f / 1024.f) + 1e-6f);
#pragma unroll
    for (int i = 0; i < 4; ++i) {
      float4 w4 = *(const float4*)(fw + (lane + 64 * i) * 4);
      float4 o;
      o.x = v[i].x * rstd * w4.x;
      o.y = v[i].y * rstd * w4.y;
      o.z = v[i].z * rstd * w4.z;
      o.w = v[i].w * rstd * w4.w;
      x4[lane + 64 * i] = o;
    }
  };
  const int stride = gridDim.x * 8;
  for (int R = blockIdx.x * 8 + wv; R < NTOK; R += 2 * stride) {
    const int R2 = R + stride;
    const bool has2 = R2 < NTOK;
    const float4* xa = (const float4*)(p.out + (size_t)R * 1024);
    const float4* xb2 = (const float4*)(p.out + (size_t)(has2 ? R2 : R) * 1024);
    float4 v[4], u[4];
#pragma unroll
    for (int i = 0; i < 4; ++i) v[i] = xa[lane + 64 * i];
#pragma unroll
    for (int i = 0; i < 4; ++i) u[i] = xb2[lane + 64 * i];
    process(R, v);
    if (has2) process(R2, u);
  }
}

#if PROBE_MASK
#define PTICK(B) { long long tq1_ = wall_clock64(); if ((PROBE_MASK >> (B)) & 1) tacc += tq1_ - tq0_; tq0_ = tq1_; }
#define PT0() long long tq0_ = wall_clock64();
#else
#define PTICK(B)
#define PT0()
#endif
__device__ __forceinline__ bf16x8 ld8(const us* ptr) { return *reinterpret_cast<const bf16x8*>(ptr); }

__device__ void gdn_prep_item(const Params& p, int item, long long& tacc) {
  PT0()
  const int t = tid_l(), lane = t & 63, w = t >> 6;
  const int tc = item >> 3, h = item & 7;
  const int r0 = tc * 64;
  int seq_lo, seq_hi;
  if (tc < 16) { seq_lo = (tc >> 2) * 256; seq_hi = seq_lo + 256; } else { seq_lo = 1024; seq_hi = 5120; }
  const int ci = item;

  char* L = (char*)shm;
  us* qs = (us*)L;
  us* ks = (us*)(L + 17408);
  float* AF = (float*)L;
  float* ABF = (float*)(L + 17408);
  us* kTb = (us*)(L + 34816);
  us* vTb = (us*)(L + 53248);
  float* vec = (float*)(L + 71680);
  float* Gv = vec;
  float* Bv = vec + 128;
  float* SCL = vec + 256;

  const us* QKV = (const us*)(p.ws + WS_QKV);
  const float* GC = (const float*)(p.ws + WS_GC);

  float* cwl2 = (float*)(L + 131072);
  if (t < 480) {
    const int rw = t / 96, rem = t - rw * 96, m = rem >> 5, c4 = (rem & 31) * 4;
    const float* srcw = rw < 4 ? IN(12) + rw * 3072 + m * 1024 + h * 128 + c4 : IN(13) + m * 1024 + h * 128 + c4;
    *(float4*)(cwl2 + rw * 384 + m * 128 + c4) = *(const float4*)srcw;
  }
  if (w == 0) {
    const int i = lane;
    const float* gc = GC + (size_t)(r0 + i) * 32;
    float af = gc[h], bfv = gc[8 + h], ab = gc[16 + h], bb = gc[24 + h];
    float gf = -__expf(IN(14)[h]) * softplusf_(af + IN(15)[h]);
    float gb = -__expf(IN(16)[h]) * softplusf_(ab + IN(17)[h]);
    float betaf = sigmoidf_(bfv), betab = sigmoidf_(bb);
    float s = gf;
    for (int o = 1; o < 64; o <<= 1) {
      float y = shfl_lane(s, lane >= o ? lane - o : lane);
      if (lane >= o) s += y;
    }
    float s2 = gb;
    for (int o = 1; o < 64; o <<= 1) {
      float y = shfl_lane(s2, lane + o < 64 ? lane + o : lane);
      if (lane + o < 64) s2 += y;
    }
    float glf = shfl_lane(s, 63), glb = shfl_lane(s2, 0);
    Gv[i] = s; Gv[64 + i] = s2;
    Bv[i] = betaf; Bv[64 + i] = betab;
    float egf = __expf(s), egb = __expf(s2);
    SCL[i] = betaf; SCL[64 + i] = betaf * egf; SCL[128 + i] = betab; SCL[192 + i] = betab * egb;
    float* EG = (float*)(p.ws + WS_EG);
    float* ES = (float*)(p.ws + WS_ES);
    float* DL = (float*)(p.ws + WS_DL);
    EG[(size_t)(ci * 2 + 0) * 64 + i] = egf;
    EG[(size_t)(ci * 2 + 1) * 64 + i] = egb;
    ES[(size_t)(ci * 2 + 0) * 64 + i] = __expf(glf - s);
    ES[(size_t)(ci * 2 + 1) * 64 + i] = __expf(glb - s2);
    if (i == 0) { DL[ci * 2 + 0] = __expf(glf); DL[ci * 2 + 1] = __expf(glb); }
  }
  lds_barrier();
  {
    const int i = t >> 3, cg8 = t & 7;
#pragma unroll
    for (int m = 0; m < 3; ++m) {
      const int col = m * 1024 + h * 128 + cg8 * 16;
      const float* cwm = cwl2 + m * 128 + cg8 * 16;
      float y[16];
#pragma unroll
      for (int c = 0; c < 16; ++c) y[c] = cwm[4 * 384 + c];
#pragma unroll
      for (int tap = 0; tap < 4; ++tap) {
        const int rr = r0 + i - 2 + tap;
        if (rr >= seq_lo && rr < seq_hi) {
          const uint4* src = (const uint4*)(QKV + (size_t)rr * 3072 + col);
          uint4 a = src[0], b = src[1];
          unsigned wds[8] = {a.x, a.y, a.z, a.w, b.x, b.y, b.z, b.w};
          const float* wt = cwm + tap * 384;
#pragma unroll
          for (int c = 0; c < 8; ++c) {
            y[2 * c] += wt[2 * c] * __uint_as_float(wds[c] << 16);
            y[2 * c + 1] += wt[2 * c + 1] * __uint_as_float(wds[c] & 0xffff0000u);
          }
        }
      }
      float ss = 0.f;
#pragma unroll
      for (int c = 0; c < 16; ++c) { y[c] = siluf_(y[c]); ss += y[c] * y[c]; }
      if (m < 2) {
        ss += shfl_lane(ss, lane ^ 1);
        ss += shfl_lane(ss, lane ^ 2);
        ss += shfl_lane(ss, lane ^ 4);
        float inv = rsqrtf(ss + 1e-6f);
        if (m == 0) inv *= 0.08838834764831845f;
#pragma unroll
        for (int c = 0; c < 16; ++c) y[c] *= inv;
      }
      if (m == 0) {
        uint4 o0, o1;
        o0.x = pack2(y[0], y[1]); o0.y = pack2(y[2], y[3]); o0.z = pack2(y[4], y[5]); o0.w = pack2(y[6], y[7]);
        o1.x = pack2(y[8], y[9]); o1.y = pack2(y[10], y[11]); o1.z = pack2(y[12], y[13]); o1.w = pack2(y[14], y[15]);
        *(uint4*)(qs + i * 136 + cg8 * 16) = o0;
        *(uint4*)(qs + i * 136 + cg8 * 16 + 8) = o1;
        us* Qg = (us*)(p.ws + WS_Q) + (size_t)ci * 8192 + i * 128 + cg8 * 16;
        *(uint4*)Qg = o0;
        *(uint4*)(Qg + 8) = o1;
      } else if (m == 1) {
        uint4 o0, o1;
        o0.x = pack2(y[0], y[1]); o0.y = pack2(y[2], y[3]); o0.z = pack2(y[4], y[5]); o0.w = pack2(y[6], y[7]);
        o1.x = pack2(y[8], y[9]); o1.y = pack2(y[10], y[11]); o1.z = pack2(y[12], y[13]); o1.w = pack2(y[14], y[15]);
        *(uint4*)(ks + i * 136 + cg8 * 16) = o0;
        *(uint4*)(ks + i * 136 + cg8 * 16 + 8) = o1;
#pragma unroll
        for (int c = 0; c < 16; ++c) kTb[(cg8 * 16 + c) * 72 + i] = f2bf(y[c]);
      } else {
#pragma unroll
        for (int c = 0; c < 16; ++c) vTb[(cg8 * 16 + c) * 72 + i] = f2bf(y[c]);
      }
    }
  }
  lds_barrier();
  PTICK(13)
  f32x4 acc[4];
  {
    const int mat = w >> 2, mt = w & 3;
    const us* Asrc = mat == 0 ? ks : qs;
#pragma unroll
    for (int n = 0; n < 4; ++n) acc[n] = f32x4{0.f, 0.f, 0.f, 0.f};
#pragma unroll
    for (int kk = 0; kk < 4; ++kk) {
      bf16x8 a = ld8(Asrc + (16 * mt + (lane & 15)) * 136 + kk * 32 + (lane >> 4) * 8);
#pragma unroll
      for (int n = 0; n < 4; ++n) {
        bf16x8 b = ld8(ks + (16 * n + (lane & 15)) * 136 + kk * 32 + (lane >> 4) * 8);
        acc[n] = __builtin_amdgcn_mfma_f32_16x16x32_bf16(a, b, acc[n], 0, 0, 0);
      }
    }
  }
  lds_barrier();
  {
    const int mat = w >> 2, mt = w & 3;
    us* QKM = (us*)(p.ws + WS_QKM);
#pragma unroll
    for (int n = 0; n < 4; ++n)
#pragma unroll
      for (int jj = 0; jj < 4; ++jj) {
        const int i = 16 * mt + 4 * (lane >> 4) + jj, j = 16 * n + (lane & 15);
        const float val = acc[n][jj];
        const float df = __expf(Gv[i] - Gv[j]);
        const float db = __expf(Gv[64 + i] - Gv[64 + j]);
        if (mat == 0) {
          AF[i * 68 + j] = (i > j) ? Bv[i] * val * df : 0.f;
          ABF[(63 - i) * 68 + (63 - j)] = (i < j) ? Bv[64 + i] * val * db : 0.f;
        } else {
          QKM[(size_t)(ci * 2 + 0) * 4096 + i * 64 + j] = f2bf((i >= j) ? val * df : 0.f);
          QKM[(size_t)(ci * 2 + 1) * 4096 + i * 64 + j] = f2bf((i <= j) ? val * db : 0.f);
        }
      }
  }
  {
    us* KT = (us*)(p.ws + WS_KT) + (size_t)ci * 8192;
    for (int idx = t; idx < 8192; idx += 512) KT[idx] = kTb[(idx >> 6) * 72 + (idx & 63)];
  }
  lds_barrier();
  PTICK(14)
  {
    const int d = w >> 2, wq = w & 3, lr = lane & 15, lq = lane >> 4;
    const float* Am = d ? ABF : AF;
    us* Sm = (us*)(L + 73728 + d * 27648);
    us* STm = Sm + 4608;
    us* Pm = STm + 4608;
    f32x4 Pacc[4], Sn[4];
#pragma unroll
    for (int nt = 0; nt < 4; ++nt)
#pragma unroll
      for (int jj = 0; jj < 4; ++jj) {
        const int row = 16 * wq + 4 * lq + jj, col = 16 * nt + lr;
        const float av = Am[row * 68 + col];
        Sn[nt][jj] = av;
        Pacc[nt][jj] = (row == col ? 1.f : 0.f) - av;
      }
    auto write_S = [&]() {
#pragma unroll
      for (int nt = 0; nt < 4; ++nt) {
        const int col = 16 * nt + lr, row0 = 16 * wq + 4 * lq;
#pragma unroll
        for (int jj = 0; jj < 4; ++jj) Sm[(row0 + jj) * 72 + col] = f2bf(Sn[nt][jj]);
        uint2 o;
        o.x = pack2(Sn[nt][0], Sn[nt][1]);
        o.y = pack2(Sn[nt][2], Sn[nt][3]);
        *(uint2*)(STm + col * 72 + row0) = o;
      }
    };
    auto write_P = [&]() {
#pragma unroll
      for (int nt = 0; nt < 4; ++nt) {
        const int col = 16 * nt + lr, row0 = 16 * wq + 4 * lq;
#pragma unroll
        for (int jj = 0; jj < 4; ++jj) Pm[(row0 + jj) * 72 + col] = f2bf(Pacc[nt][jj]);
      }
    };
    write_S();
    write_P();
    lds_barrier();
    {
      f32x4 acc2[4];
#pragma unroll
      for (int nt = 0; nt < 4; ++nt) acc2[nt] = f32x4{0.f, 0.f, 0.f, 0.f};
#pragma unroll
      for (int kk = 0; kk < 2; ++kk) {
        bf16x8 af = ld8(Sm + (16 * wq + lr) * 72 + kk * 32 + lq * 8);
#pragma unroll
        for (int nt = 0; nt < 4; ++nt) {
          bf16x8 bfr = ld8(STm + (16 * nt + lr) * 72 + kk * 32 + lq * 8);
          acc2[nt] = __builtin_amdgcn_mfma_f32_16x16x32_bf16(af, bfr, acc2[nt], 0, 0, 0);
        }
      }
#pragma unroll
      for (int nt = 0; nt < 4; ++nt) Sn[nt] = acc2[nt];
    }
    lds_barrier();
    write_S();
#pragma unroll 1
    for (int k = 1; k <= 5; ++k) {
      lds_barrier();
      f32x4 acc2[4];
#pragma unroll
      for (int nt = 0; nt < 4; ++nt) acc2[nt] = f32x4{0.f, 0.f, 0.f, 0.f};
#pragma unroll
      for (int kk = 0; kk < 2; ++kk) {
        bf16x8 pf = ld8(Pm + (16 * wq + lr) * 72 + kk * 32 + lq * 8);
        bf16x8 sf = ld8(Sm + (16 * wq + lr) * 72 + kk * 32 + lq * 8);
#pragma unroll
        for (int nt = 0; nt < 4; ++nt) {
          bf16x8 bfr = ld8(STm + (16 * nt + lr) * 72 + kk * 32 + lq * 8);
          Pacc[nt] = __builtin_amdgcn_mfma_f32_16x16x32_bf16(pf, bfr, Pacc[nt], 0, 0, 0);
          acc2[nt] = __builtin_amdgcn_mfma_f32_16x16x32_bf16(sf, bfr, acc2[nt], 0, 0, 0);
        }
      }
#pragma unroll
      for (int nt = 0; nt < 4; ++nt) Sn[nt] = acc2[nt];
      lds_barrier();
      if (k < 5) {
        write_S();
        write_P();
      }
    }
    {
#pragma unroll
      for (int nt = 0; nt < 4; ++nt)
#pragma unroll
        for (int jj = 0; jj < 4; ++jj) {
          Pacc[nt][jj] = bf2f(f2bf(Pacc[nt][jj]));
          Sn[nt][jj] = Pacc[nt][jj];
        }
      write_S();
      lds_barrier();
      f32x4 Racc[4];
#pragma unroll
      for (int nt = 0; nt < 4; ++nt)
#pragma unroll
        for (int jj = 0; jj < 4; ++jj) Racc[nt][jj] = ((16 * wq + 4 * lq + jj) == (16 * nt + lr)) ? 1.f : 0.f;
#pragma unroll
      for (int kk = 0; kk < 2; ++kk) {
        const int rr = 16 * wq + lr, k0 = kk * 32 + lq * 8;
        const float* ar = Am + rr * 68 + k0;
        bf16x8 hi, lo;
#pragma unroll
        for (int e = 0; e < 8; ++e) {
          const float lv = -(ar[e] + (rr == k0 + e ? 1.f : 0.f));
          const us hb = f2bf(lv);
          hi[e] = (short)hb;
          lo[e] = (short)f2bf(lv - bf2f(hb));
        }
#pragma unroll
        for (int nt = 0; nt < 4; ++nt) {
          bf16x8 bfr = ld8(STm + (16 * nt + lr) * 72 + kk * 32 + lq * 8);
          Racc[nt] = __builtin_amdgcn_mfma_f32_16x16x32_bf16(hi, bfr, Racc[nt], 0, 0, 0);
          Racc[nt] = __builtin_amdgcn_mfma_f32_16x16x32_bf16(lo, bfr, Racc[nt], 0, 0, 0);
        }
      }
#pragma unroll
      for (int nt = 0; nt < 4; ++nt) {
        uint2 o;
        o.x = pack2(Racc[nt][0], Racc[nt][1]);
        o.y = pack2(Racc[nt][2], Racc[nt][3]);
        *(uint2*)(Pm + (16 * nt + lr) * 72 + 16 * wq + 4 * lq) = o;
      }
      lds_barrier();
#pragma unroll
      for (int kk = 0; kk < 2; ++kk) {
        bf16x8 af = ld8(Sm + (16 * wq + lr) * 72 + kk * 32 + lq * 8);
#pragma unroll
        for (int nt = 0; nt < 4; ++nt) {
          bf16x8 bfr = ld8(Pm + (16 * nt + lr) * 72 + kk * 32 + lq * 8);
          Pacc[nt] = __builtin_amdgcn_mfma_f32_16x16x32_bf16(af, bfr, Pacc[nt], 0, 0, 0);
        }
      }
      lds_barrier();
    }
    {
      const float* sclU = SCL + (d * 2 + 0) * 64;
      const float* sclW = SCL + (d * 2 + 1) * 64;
#pragma unroll
      for (int nt = 0; nt < 4; ++nt)
#pragma unroll
        for (int jj = 0; jj < 4; ++jj) {
          const int ip = 16 * wq + 4 * lq + jj, jp = 16 * nt + lr;
          const int i = d ? 63 - ip : ip, j = d ? 63 - jp : jp;
          const float tv = Pacc[nt][jj];
          Sm[i * 72 + j] = f2bf(tv * sclU[j]);
          STm[i * 72 + j] = f2bf(tv * sclW[j]);
        }
    }
    lds_barrier();
    PTICK(15)
#pragma unroll 1
    for (int isW = 0; isW < 2; ++isW) {
      const us* Tm = isW ? STm : Sm;
      const us* Bm = isW ? kTb : vTb;
      f32x4 accU[8];
#pragma unroll
      for (int nt = 0; nt < 8; ++nt) accU[nt] = f32x4{0.f, 0.f, 0.f, 0.f};
#pragma unroll
      for (int kk = 0; kk < 2; ++kk) {
        bf16x8 af = ld8(Tm + (16 * wq + lr) * 72 + kk * 32 + lq * 8);
#pragma unroll
        for (int nt = 0; nt < 8; ++nt) {
          bf16x8 bfr = ld8(Bm + (16 * nt + lr) * 72 + kk * 32 + lq * 8);
          accU[nt] = __builtin_amdgcn_mfma_f32_16x16x32_bf16(af, bfr, accU[nt], 0, 0, 0);
        }
      }
      us* dst = (us*)(p.ws + (isW ? WS_WN : WS_U)) + (size_t)(ci * 2 + d) * 8192;
      if (isW) {
#pragma unroll
        for (int nt = 0; nt < 8; ++nt)
#pragma unroll
          for (int jj = 0; jj < 4; ++jj) dst[(16 * wq + 4 * lq + jj) * 128 + 16 * nt + lr] = f2bf(-accU[nt][jj]);
      } else {
#pragma unroll
        for (int sl2 = 0; sl2 < 4; ++sl2) {
          uint4 o;
          o.x = pack2(accU[2 * sl2][0], accU[2 * sl2][1]);
          o.y = pack2(accU[2 * sl2][2], accU[2 * sl2][3]);
          o.z = pack2(accU[2 * sl2 + 1][0], accU[2 * sl2 + 1][1]);
          o.w = pack2(accU[2 * sl2 + 1][2], accU[2 * sl2 + 1][3]);
          *(uint4*)(dst + ((sl2 * 4 + wq) * 64 + lane) * 8) = o;
        }
      }
    }
  }
  lds_barrier();
  PTICK(16)
}

__device__ void gdn_seq_item(const Params& p, int g, int item, us* OF, us* OB) {
  const int t = tid_l(), lane = t & 63, w = __builtin_amdgcn_readfirstlane(t >> 6);
  int h, d, sl, tc0, nch, seq = -1;
  if (item < 64) { h = item >> 3; d = (item >> 2) & 1; sl = item & 3; tc0 = 16; nch = 64; }
  else { int it = item - 64; seq = it >> 6; int rem = it & 63; h = rem >> 3; d = (rem >> 2) & 1; sl = rem & 3; tc0 = seq * 4; nch = 4; }
  char* L = (char*)shm;
  us* sT = (us*)L;
  us* vT = (us*)(L + 8704);
  us* vsT = (us*)(L + 8704 + 4608);
  const us* Qb = (const us*)(p.ws + WS_Q);
  const us* KTb = (const us*)(p.ws + WS_KT);
  const us* WNb = (const us*)(p.ws + WS_WN);
  const us* Ub = (const us*)(p.ws + WS_U);
  const us* QKMb = (const us*)(p.ws + WS_QKM);
  const float* EG = (const float*)(p.ws + WS_EG);
  const float* ES = (const float*)(p.ws + WS_ES);
  const float* DL = (const float*)(p.ws + WS_DL);
  us* O = d ? OB : OF;
  const int lr = lane & 15, lq = lane >> 4;

  f32x4 s[2];
  if (seq < 0) {
    const float* st = IN(d ? 3 : 2) + ((size_t)(g * 8 + h) * 128) * 128;
#pragma unroll
    for (int nt = 0; nt < 2; ++nt)
#pragma unroll
      for (int jj = 0; jj < 4; ++jj) s[nt][jj] = st[(size_t)(16 * w + 4 * lq + jj) * 128 + sl * 32 + 16 * nt + lr];
  } else {
    s[0] = f32x4{0.f, 0.f, 0.f, 0.f};
    s[1] = f32x4{0.f, 0.f, 0.f, 0.f};
  }
  lds_barrier();
#pragma unroll
  for (int nt = 0; nt < 2; ++nt) {
    uint2 o;
    o.x = pack2(s[nt][0], s[nt][1]);
    o.y = pack2(s[nt][2], s[nt][3]);
    *(uint2*)(sT + (16 * nt + lr) * 136 + 16 * w + 4 * lq) = o;
  }
  lds_barrier();

  struct Ops {
    bf16x8 a[4];
    bf16x8 qk[2];
    bf16x8 kt[2];
    uint4 u;
    float e[4];
    float dl;
  };
  const int mt = w & 3;
  auto load_a = [&](int step, Ops& o) {
    const int c = d ? nch - 1 - step : step;
    const int tc = tc0 + c;
    const int ci = tc * 8 + h, cd = ci * 2 + d;
    const us* Ap = (w < 4) ? (WNb + (size_t)cd * 8192) : (Qb + (size_t)ci * 8192);
#pragma unroll
    for (int kk = 0; kk < 4; ++kk) o.a[kk] = ld8(Ap + (16 * mt + lr) * 128 + kk * 32 + lq * 8);
    if (w < 4) {
      o.u = *(const uint4*)(Ub + (size_t)cd * 8192 + ((sl * 4 + mt) * 64 + lane) * 8);
      const float4 e4 = *(const float4*)(ES + (size_t)cd * 64 + 16 * mt + 4 * lq);
      o.e[0] = e4.x; o.e[1] = e4.y; o.e[2] = e4.z; o.e[3] = e4.w;
    } else {
      const float4 e4 = *(const float4*)(EG + (size_t)cd * 64 + 16 * mt + 4 * lq);
      o.e[0] = e4.x; o.e[1] = e4.y; o.e[2] = e4.z; o.e[3] = e4.w;
    }
  };
  auto load_b = [&](int step, Ops& o) {
    const int c = d ? nch - 1 - step : step;
    const int tc = tc0 + c;
    const int ci = tc * 8 + h, cd = ci * 2 + d;
    const us* Kp = KTb + (size_t)ci * 8192;
#pragma unroll
    for (int kk = 0; kk < 2; ++kk) o.kt[kk] = ld8(Kp + (16 * w + lr) * 64 + kk * 32 + lq * 8);
    o.dl = DL[cd];
    if (w >= 4) {
      const us* Qp = QKMb + (size_t)cd * 4096;
#pragma unroll
      for (int kk = 0; kk < 2; ++kk) o.qk[kk] = ld8(Qp + (16 * mt + lr) * 64 + kk * 32 + lq * 8);
    }
  };
  Ops ring[4];
  load_a(0, ring[0]); load_b(0, ring[0]);
  load_a(1, ring[1]); load_b(1, ring[1]);
  load_a(2, ring[2]); load_b(2, ring[2]);
  auto do_step = [&](int step, int tc, int nstep, auto STc) {
    constexpr int ST = decltype(STc)::value;
    f32x4 acc[2];
    {
      if (w < 4) {
        const uint4 uu = ring[ST].u;
        acc[0][0] = __uint_as_float(uu.x << 16); acc[0][1] = __uint_as_float(uu.x & 0xffff0000u);
        acc[0][2] = __uint_as_float(uu.y << 16); acc[0][3] = __uint_as_float(uu.y & 0xffff0000u);
        acc[1][0] = __uint_as_float(uu.z << 16); acc[1][1] = __uint_as_float(uu.z & 0xffff0000u);
        acc[1][2] = __uint_as_float(uu.w << 16); acc[1][3] = __uint_as_float(uu.w & 0xffff0000u);
      } else {
        acc[0] = f32x4{0.f, 0.f, 0.f, 0.f};
        acc[1] = f32x4{0.f, 0.f, 0.f, 0.f};
      }
#pragma unroll
      for (int kk = 0; kk < 4; ++kk)
#pragma unroll
        for (int nt = 0; nt < 2; ++nt) {
          bf16x8 b = ld8(sT + (16 * nt + lr) * 136 + kk * 32 + lq * 8);
          acc[nt] = __builtin_amdgcn_mfma_f32_16x16x32_bf16(ring[ST].a[kk], b, acc[nt], 0, 0, 0);
        }
    }
    if (w < 4) {
#pragma unroll
      for (int nt = 0; nt < 2; ++nt) {
        uint2 o, o2;
        o.x = pack2(acc[nt][0], acc[nt][1]);
        o.y = pack2(acc[nt][2], acc[nt][3]);
        o2.x = pack2(acc[nt][0] * ring[ST].e[0], acc[nt][1] * ring[ST].e[1]);
        o2.y = pack2(acc[nt][2] * ring[ST].e[2], acc[nt][3] * ring[ST].e[3]);
        *(uint2*)(vT + (16 * nt + lr) * 72 + 16 * mt + 4 * lq) = o;
        *(uint2*)(vsT + (16 * nt + lr) * 72 + 16 * mt + 4 * lq) = o2;
      }
    }
    lds_barrier();
    load_b(nstep, ring[(ST + 3) & 3]);
    if (w >= 4) {
#pragma unroll
      for (int nt = 0; nt < 2; ++nt)
#pragma unroll
        for (int jj = 0; jj < 4; ++jj) acc[nt][jj] *= ring[ST].e[jj];
#pragma unroll
      for (int kk = 0; kk < 2; ++kk) {
#pragma unroll
        for (int nt = 0; nt < 2; ++nt) {
          bf16x8 b = ld8(vT + (16 * nt + lr) * 72 + kk * 32 + lq * 8);
          acc[nt] = __builtin_amdgcn_mfma_f32_16x16x32_bf16(ring[ST].qk[kk], b, acc[nt], 0, 0, 0);
        }
      }
      const int rbase = tc * 64 + 16 * mt + 4 * lq;
#pragma unroll
      for (int nt = 0; nt < 2; ++nt)
#pragma unroll
        for (int jj = 0; jj < 4; ++jj) O[(size_t)(rbase + jj) * 1024 + h * 128 + sl * 32 + 16 * nt + lr] = f2bf(acc[nt][jj]);
    }
    {
#pragma unroll
      for (int nt = 0; nt < 2; ++nt)
#pragma unroll
        for (int jj = 0; jj < 4; ++jj) s[nt][jj] *= ring[ST].dl;
#pragma unroll
      for (int kk = 0; kk < 2; ++kk) {
#pragma unroll
        for (int nt = 0; nt < 2; ++nt) {
          bf16x8 b = ld8(vsT + (16 * nt + lr) * 72 + kk * 32 + lq * 8);
          s[nt] = __builtin_amdgcn_mfma_f32_16x16x32_bf16(ring[ST].kt[kk], b, s[nt], 0, 0, 0);
        }
      }
#pragma unroll
      for (int nt = 0; nt < 2; ++nt) {
        uint2 o;
        o.x = pack2(s[nt][0], s[nt][1]);
        o.y = pack2(s[nt][2], s[nt][3]);
        *(uint2*)(sT + (16 * nt + lr) * 136 + 16 * w + 4 * lq) = o;
      }
    }
    lds_barrier();
  };
  for (int step0 = 0; step0 < nch; step0 += 4) {
#define SEQ_SUB(K)                                                                 \
    {                                                                              \
      const int step = step0 + K;                                                  \
      const int c = d ? nch - 1 - step : step;                                     \
      const int nstep = step + 3 < nch ? step + 3 : nch - 1;                       \
      load_a(nstep, ring[(K + 3) & 3]);                                            \
      do_step(step, tc0 + c, nstep, std::integral_constant<int, K>{});             \
    }
    SEQ_SUB(0) SEQ_SUB(1) SEQ_SUB(2) SEQ_SUB(3)
#undef SEQ_SUB
  }
  if (seq >= 0) {
    const int b = g * 4 + seq;
    float* dst = p.out + (d ? OUT_SAB : OUT_SAF) + ((size_t)(b * 8 + h) * 128) * 128;
#pragma unroll
    for (int nt = 0; nt < 2; ++nt)
#pragma unroll
      for (int jj = 0; jj < 4; ++jj) dst[(size_t)(16 * w + 4 * lq + jj) * 128 + sl * 32 + 16 * nt + lr] = s[nt][jj];
  }
}

__device__ __forceinline__ int lru_row(int sc, int jj) {
  if (sc < 16) {
    int j = (sc & 3) * 64 + jj;
    if (j < 0 || j >= 256) return -1;
    return (sc >> 2) * 256 + j;
  } else {
    int j = (sc - 16) * 64 + jj;
    if (j < 0 || j >= 4096) return -1;
    return 1024 + (j & 63) * 64 + (j >> 6);
  }
}

__device__ void lru_item(const Params& p, int g, int item, int pass, long long& tacc) {
  PT0()
  const int t = tid_l(), lane = t & 63, w = t >> 6;
  const int sc = item >> 3, blk = item & 7;
  const int lr = lane & 15, lq = lane >> 4;
  char* L = (char*)shm;
  constexpr int LS = 132;
  float* xcf = (float*)L;
  float* Aa = (float*)(L + 33792);
  float* Bb = (float*)(L + 67584);
  float* HF = (float*)(L + 101376);
  us* xcb = (us*)(L + 101376);
  float* carry = (float*)(L + 135168);
  float* stage = (float*)(L + 33792);
  const us* XB = (const us*)(p.ws + ((g & 1) ? WS_XB2 : WS_XB));
  float* AGG = (float*)(p.ws + WS_AGG);
  const int cidx = sc < 16 ? (sc & 3) : sc - 16;
  const int nch = sc < 16 ? 4 : 64;
  const int sc0 = sc < 16 ? (sc & ~3) : 16;

  bf16x8 wfr[4][4];
  float prm[2][3];
  {
    const us* WL = (const us*)(p.ws + WS_WL) + (size_t)blk * 512 * 128;
#pragma unroll
    for (int kk = 0; kk < 4; ++kk)
#pragma unroll
      for (int ty = 0; ty < 4; ++ty) wfr[kk][ty] = ld8(WL + (size_t)(ty * 128 + 16 * w + lr) * 128 + kk * 32 + lq * 8);
    const int chp = blk * 128 + 16 * w + lr;
    prm[0][0] = IN(22)[chp]; prm[0][1] = IN(24)[chp]; prm[0][2] = IN(25)[chp];
    prm[1][0] = IN(27)[chp]; prm[1][1] = IN(29)[chp]; prm[1][2] = IN(30)[chp];
  }
  float* cwl = (float*)(L + 140288);
  float4 cwv = make_float4(0.f, 0.f, 0.f, 0.f);
  if (t < 160) {
    const int rw = t >> 5, c4 = (t & 31) * 4;
    const float* srcw = rw < 4 ? IN(19) + rw * 1024 + blk * 128 + c4 : IN(20) + blk * 128 + c4;
    cwv = *(const float4*)srcw;
  }
  lds_barrier();
  if (t < 160) *(float4*)(cwl + t * 4) = cwv;
  if (pass == 1) {
    const int nf = cidx, nb = nch - 1 - cidx;
    for (int idx = t; idx < (nf + nb) * 64; idx += 512) {
      int e = idx >> 6, rem = idx & 63, ab = rem >> 5, c4 = (rem & 31) * 4;
      int cp, dir;
      if (e < nf) { cp = e; dir = 0; } else { cp = nch - 1 - (e - nf); dir = 1; }
      *(float4*)(stage + e * 256 + ab * 128 + c4) =
          *(const float4*)(AGG + ((size_t)((sc0 + cp) * 2 + dir) * 2 + ab) * 1024 + blk * 128 + c4);
    }
    lds_barrier();
    if (t < 256) {
      const int dir = t >> 7, ch = t & 127;
      float hh = 0.f;
      if (sc >= 16) hh = IN(dir ? 5 : 4)[(size_t)g * 1024 + blk * 128 + ch];
      const int e0 = dir ? nf : 0, ne = dir ? nb : nf;
      for (int e = 0; e < ne; ++e) hh = stage[(e0 + e) * 256 + ch] * hh + stage[(e0 + e) * 256 + 128 + ch];
      carry[dir * 128 + ch] = hh;
    }
    lds_barrier();
  }
  PTICK(17)
  lds_barrier();
  {
    const int pp = t >> 3, cg8 = t & 7;
    const int chg = blk * 128 + cg8 * 16;
    float y[16];
#pragma unroll
    for (int c = 0; c < 16; ++c) y[c] = cwl[4 * 128 + cg8 * 16 + c];
#pragma unroll
    for (int tap = 0; tap < 4; ++tap) {
      const int row = lru_row(sc, pp - 2 + tap);
      if (row >= 0) {
        const uint4* src = (const uint4*)(XB + (size_t)row * 1024 + chg);
        uint4 a = src[0], b = src[1];
        unsigned wds[8] = {a.x, a.y, a.z, a.w, b.x, b.y, b.z, b.w};
        const float* wt = cwl + tap * 128 + cg8 * 16;
#pragma unroll
        for (int c = 0; c < 8; ++c) {
          y[2 * c] += wt[2 * c] * __uint_as_float(wds[c] << 16);
          y[2 * c + 1] += wt[2 * c + 1] * __uint_as_float(wds[c] & 0xffff0000u);
        }
      }
    }
#pragma unroll
    for (int c = 0; c < 16; ++c) xcf[pp * LS + cg8 * 16 + c] = y[c];
    uint4 o0, o1;
    o0.x = pack2(y[0], y[1]); o0.y = pack2(y[2], y[3]); o0.z = pack2(y[4], y[5]); o0.w = pack2(y[6], y[7]);
    o1.x = pack2(y[8], y[9]); o1.y = pack2(y[10], y[11]); o1.z = pack2(y[12], y[13]); o1.w = pack2(y[14], y[15]);
    *(uint4*)(xcb + pp * 136 + cg8 * 16) = o0;
    *(uint4*)(xcb + pp * 136 + cg8 * 16 + 8) = o1;
  }
  lds_barrier();
  PTICK(18)
  f32x4 acc[4][4];
  {
#pragma unroll
    for (int ty = 0; ty < 4; ++ty)
#pragma unroll
      for (int m = 0; m < 4; ++m) acc[ty][m] = f32x4{0.f, 0.f, 0.f, 0.f};
#pragma unroll
    for (int kk = 0; kk < 4; ++kk) {
      bf16x8 a[4];
#pragma unroll
      for (int m = 0; m < 4; ++m) a[m] = ld8(xcb + (16 * m + lr) * 136 + kk * 32 + lq * 8);
#pragma unroll
      for (int ty = 0; ty < 4; ++ty)
#pragma unroll
        for (int m = 0; m < 4; ++m) acc[ty][m] = __builtin_amdgcn_mfma_f32_16x16x32_bf16(a[m], wfr[kk][ty], acc[ty][m], 0, 0, 0);
    }
  }
  lds_barrier();
  PTICK(19)
  const int chl = 16 * w + lr, chg1 = blk * 128 + chl;
#pragma unroll
  for (int dir = 0; dir < 2; ++dir) {
    {
      const float ba = prm[dir][0], bx = prm[dir][1];
      const float spl = softplusf_(-prm[dir][2]);
#pragma unroll
      for (int m = 0; m < 4; ++m)
#pragma unroll
        for (int jj = 0; jj < 4; ++jj) {
          const int pos = 16 * m + 4 * lq + jj;
          float r = sigmoidf_(acc[dir * 2][m][jj] + ba);
          float ig = sigmoidf_(acc[dir * 2 + 1][m][jj] + bx);
          float la = -8.f * r * spl;
          float a = __expf(la);
          float bb = __builtin_amdgcn_sqrtf(fmaxf(1.f - a * a, 0.f)) * ig * xcf[pos * LS + chl];
          Aa[pos * LS + chl] = a;
          Bb[pos * LS + chl] = bb;
        }
    }
    lds_barrier();
    PTICK(20)
    {
      float* SA = carry + 256;
      float* SB = carry + 768;
      const int seg = t >> 7, ch = t & 127, chg = blk * 128 + ch;
      const int pbase = dir ? 63 - 16 * seg : 16 * seg;
      const int pstep = dir ? -LS : LS;
      float* ap_ = Aa + pbase * LS + ch;
      float* bp_ = Bb + pbase * LS + ch;
      float av[16], bv[16];
#pragma unroll
      for (int i = 0; i < 16; ++i) { av[i] = ap_[i * pstep]; bv[i] = bp_[i * pstep]; }
      float prod = 1.f, hh = 0.f;
#pragma unroll
      for (int i = 0; i < 16; ++i) { hh = av[i] * hh + bv[i]; prod *= av[i]; av[i] = prod; bv[i] = hh; }
      SA[seg * 128 + ch] = prod;
      SB[seg * 128 + ch] = hh;
      lds_barrier();
      if (pass == 0) {
        if (seg == 0) {
          float pa = 1.f, hb = 0.f;
#pragma unroll
          for (int s2 = 0; s2 < 4; ++s2) { const float a2 = SA[s2 * 128 + ch]; hb = a2 * hb + SB[s2 * 128 + ch]; pa *= a2; }
          AGG[((size_t)(sc * 2 + dir) * 2 + 0) * 1024 + chg] = pa;
          AGG[((size_t)(sc * 2 + dir) * 2 + 1) * 1024 + chg] = hb;
        }
      } else {
        float cin = carry[dir * 128 + ch];
        for (int s2 = 0; s2 < seg; ++s2) cin = SA[s2 * 128 + ch] * cin + SB[s2 * 128 + ch];
        float* hp_ = HF + pbase * LS + ch;
        float hlast = 0.f;
#pragma unroll
        for (int i = 0; i < 16; ++i) {
          const float hv = bv[i] + av[i] * cin;
          if (dir == 0) hp_[i * pstep] = hv; else hp_[i * pstep] += hv;
          hlast = hv;
        }
        if (seg == 3 && sc < 16) {
          if (dir == 0 && cidx == 3) p.out[OUT_SBF + (size_t)(g * 4 + (sc >> 2)) * 1024 + chg] = hlast;
          if (dir == 1 && cidx == 0) p.out[OUT_SBB + (size_t)(g * 4 + (sc >> 2)) * 1024 + chg] = hlast;
        }
      }
    }
    lds_barrier();
  }
  PTICK(21)
  if (pass == 1) {
    us* OCAT = (us*)(p.ws + WS_OCAT);
    const int pp = t >> 3, cg8 = t & 7;
    const int R = grow(g, lru_row(sc, pp));
    const float* hs = HF + pp * LS + cg8 * 16;
    uint4 o0, o1;
    o0.x = pack2(hs[0], hs[1]); o0.y = pack2(hs[2], hs[3]); o0.z = pack2(hs[4], hs[5]); o0.w = pack2(hs[6], hs[7]);
    o1.x = pack2(hs[8], hs[9]); o1.y = pack2(hs[10], hs[11]); o1.z = pack2(hs[12], hs[13]); o1.w = pack2(hs[14], hs[15]);
    us* dst = OCAT + (size_t)R * 2048 + 1024 + blk * 128 + cg8 * 16;
    *(uint4*)dst = o0;
    *(uint4*)(dst + 8) = o1;
  }
  lds_barrier();
}

__device__ void phase_finalize(const Params& p, int g, const us* OF, const us* OB, bool upper_half) {
  const int t_ = tid_l();
  const int lane = t_ & 63, wv = t_ >> 6;
  const float* ow = IN(18);
  us* OCAT = (us*)(p.ws + WS_OCAT);
  const bool half = upper_half && gridDim.x >= 256;
  const int vb = half ? (int)blockIdx.x - (int)(gridDim.x >> 1) : (int)blockIdx.x;
  const int nvb = half ? (int)(gridDim.x >> 1) : (int)gridDim.x;
  if (vb < 0) return;
  for (int r = vb * 8 + wv; r < GR; r += nvb * 8) {
    const int R = grow(g, r);
    const int e0 = lane * 16;
    float o[16];
    float ss = 0.f;
    {
      const uint4* pa = (const uint4*)(OF + (size_t)r * 1024 + e0);
      const uint4* pb = (const uint4*)(OB + (size_t)r * 1024 + e0);
      const uint4 a0 = pa[0], a1 = pa[1], b0 = pb[0], b1 = pb[1];
      const unsigned wa[8] = {a0.x, a0.y, a0.z, a0.w, a1.x, a1.y, a1.z, a1.w};
      const unsigned wb[8] = {b0.x, b0.y, b0.z, b0.w, b1.x, b1.y, b1.z, b1.w};
#pragma unroll
      for (int i = 0; i < 8; ++i) {
        o[2 * i] = __uint_as_float(wa[i] << 16) + __uint_as_float(wb[i] << 16);
        o[2 * i + 1] = __uint_as_float(wa[i] & 0xffff0000u) + __uint_as_float(wb[i] & 0xffff0000u);
      }
    }
#pragma unroll
    for (int i = 0; i < 16; ++i) ss += o[i] * o[i];
    ss += shfl_lane(ss, lane ^ 1);
    ss += shfl_lane(ss, lane ^ 2);
    ss += shfl_lane(ss, lane ^ 4);
    const float rstd = rsqrtf(ss * (1.f / 128.f) + 1e-6f);
    const int wo = (lane & 7) * 16;
    uint4 o0, o1;
    float y[16];
#pragma unroll
    for (int i = 0; i < 16; ++i) y[i] = o[i] * rstd * ow[wo + i];
    o0.x = pack2(y[0], y[1]); o0.y = pack2(y[2], y[3]); o0.z = pack2(y[4], y[5]); o0.w = pack2(y[6], y[7]);
    o1.x = pack2(y[8], y[9]); o1.y = pack2(y[10], y[11]); o1.z = pack2(y[12], y[13]); o1.w = pack2(y[14], y[15]);
    us* dst = OCAT + (size_t)R * 2048 + e0;
    *(uint4*)dst = o0;
    *(uint4*)(dst + 8) = o1;
  }
}

#define XB_TMO      128
#define XB_XCNT(j)  (256  + 64 * (j))
#define XB_XSUB(j)  (1280 + 64 * (j))
#define XB_XGEN(j)  (2304 + 64 * (j))
#define XB_TOP      3328
#define XB_TOPGEN   3392
#define XCD_BAR_WORDS 3456
#define XB_SPIN_CAP (1u << 18)
#define LAS __attribute__((address_space(3)))

__device__ __forceinline__ unsigned xb_ld(unsigned* p)              { return __hip_atomic_load(p, __ATOMIC_RELAXED, __HIP_MEMORY_SCOPE_AGENT); }
__device__ __forceinline__ unsigned xb_add(unsigned* p, unsigned v) { return __hip_atomic_fetch_add(p, v, __ATOMIC_RELAXED, __HIP_MEMORY_SCOPE_AGENT); }
__device__ __forceinline__ unsigned xb_xcc_id() { return (unsigned)__builtin_amdgcn_s_getreg((3 << 11) | 20) & 0xFu; }
#define XB_SPIN(cond, bar) do { unsigned _sp = 0; while (cond) { __builtin_amdgcn_s_sleep(1); \
    if ((++_sp & 255u) == 0u) { if (xb_ld(&(bar)[XB_TMO])) break; if (_sp > XB_SPIN_CAP) { atomicAdd(&(bar)[XB_TMO], 1u); break; } } } } while (0)

struct XcdBarrier {
    unsigned* bar; unsigned x;
    volatile LAS unsigned* st;
};

__device__ __forceinline__ XcdBarrier xcd_barrier_post(unsigned* bar, volatile LAS unsigned* st) {
    XcdBarrier b; b.bar = bar; b.x = xb_xcc_id(); b.st = st;
    if (threadIdx.x == 0) (void)xb_add(&bar[XB_XCNT(b.x)], 1u);
    return b;
}
__device__ __forceinline__ void xcd_barrier_complete(unsigned* bar, unsigned x, unsigned& nloc, unsigned& nx) {
    const unsigned G = gridDim.x * gridDim.y * gridDim.z;
    unsigned sum, cnt, mine, sp = 0u;
    for (;;) {
        sum = 0u; cnt = 0u; mine = 0u;
#pragma unroll
        for (unsigned j = 0; j < 16; ++j) { const unsigned c = xb_ld(&bar[XB_XCNT(j)]); sum += c; cnt += (c > 0u) ? 1u : 0u; mine = (j == x) ? c : mine; }
        if (sum == G) break;
        __builtin_amdgcn_s_sleep(1);
        if ((++sp & 255u) == 0u) { if (xb_ld(&bar[XB_TMO])) break; if (sp > XB_SPIN_CAP) { atomicAdd(&bar[XB_TMO], 1u); break; } }
    }
    nloc = mine > 0u ? mine : 1u; nx = cnt > 0u ? cnt : 1u;
}

__device__ __forceinline__ void xcd_barrier(const XcdBarrier& b) {
    asm volatile("s_waitcnt vmcnt(0)" ::: "memory");
    __syncthreads();
    if (threadIdx.x == 0) {
        unsigned* bar = b.bar;
        __builtin_amdgcn_s_waitcnt(0);
        unsigned nloc = b.st[0], nx = b.st[1];
        if (nloc == 0u) { xcd_barrier_complete(bar, b.x, nloc, nx); b.st[0] = nloc; b.st[1] = nx; }
        const unsigned old = xb_add(&bar[XB_XSUB(b.x)], 1u);
        const unsigned gen = old / nloc;
        if (old + 1u == (gen + 1u) * nloc) {
            __builtin_amdgcn_fence(__ATOMIC_RELEASE, "agent");
            asm volatile("s_waitcnt vmcnt(0)" ::: "memory");
            const unsigned og = xb_add(&bar[XB_TOP], 1u);
            const unsigned tg = og / nx;
            if (og + 1u == (tg + 1u) * nx) xb_add(&bar[XB_TOPGEN], 1u);
            else XB_SPIN(xb_ld(&bar[XB_TOPGEN]) == tg, bar);
            __builtin_amdgcn_fence(__ATOMIC_ACQUIRE, "agent");
            xb_add(&bar[XB_XGEN(b.x)], 1u);
            asm volatile("s_waitcnt vmcnt(0)" ::: "memory");
        } else {
            XB_SPIN(xb_ld(&bar[XB_XGEN(b.x)]) == gen, bar);
            __builtin_amdgcn_fence(__ATOMIC_ACQUIRE, "agent");
            asm volatile("s_waitcnt vmcnt(0)" ::: "memory");
        }
    }
    __syncthreads();
}


__global__ void __launch_bounds__(512) fwd_megakernel(Params p) {
  cg::grid_group grid = cg::this_grid();
#define XB_WORDS ((volatile LAS unsigned*)((LAS char*)shm + (LDS_BYTES - 16)))
  if (threadIdx.x == 0) { XB_WORDS[0] = 0u; XB_WORDS[1] = 0u; }
  __syncthreads();
  (void)xcd_barrier_post((unsigned*)(p.ws + WS_BAR), XB_WORDS);
#define GRID_BAR()                                                                                 \
  {                                                                                                \
    XcdBarrier xb_;                                                                                \
    xb_.bar = (unsigned*)(p.ws + WS_BAR + zopaque());                                              \
    xb_.x = xb_xcc_id();                                                                           \
    xb_.st = XB_WORDS;                                                                             \
    xcd_barrier(xb_);                                                                              \
  }
#define H_PTR ((bf16*)p.out)
#define OF_PTR ((us*)(p.ws + WS_OF))
#define OB_PTR ((us*)(p.ws + WS_OB))

#ifndef PROBE_MASK
#define PROBE_MASK 0
#endif
  long long tacc = 0;
#if PROBE_MASK
  long long tprev = wall_clock64();
#define TICK(PH)                                              \
  {                                                           \
    long long tn_ = wall_clock64();                           \
    if ((PROBE_MASK >> (PH)) & 1) tacc += tn_ - tprev;        \
    tprev = tn_;                                              \
  }
#define WCLK() wall_clock64()
#else
#define TICK(PH)
#define WCLK() 0ll
#endif
  phase_mod(p);
  phase_weights(p);
  GRID_BAR()
  if (p.ws == nullptr) grid.sync();
  TICK(0)
  phase_h(p, H_PTR);
  GRID_BAR()
  TICK(1)
  for (int ph_ = 0; ph_ <= NG + 1; ++ph_) {
    const int ph = __builtin_amdgcn_readfirstlane(ph_);
    {
      const int b = blockIdx.x;
      const bool seqph = (ph > 0) && (ph <= NG);
      const bool lat = seqph && (gridDim.x >= 128) && (b < 64);
      const int nG = (ph < NG) ? 340 : 0;
      const int nB = (ph == NG) ? 36 * 16 : (ph == NG + 1 ? 44 * 16 : 0);
      const int nL = seqph ? 640 : 0;
      const int nC = seqph ? ((gridDim.x >= 128) ? 256 : 320) : 0;
      const int c0 = (gridDim.x >= 128) ? 64 : 0;
      unsigned* qctr = (unsigned*)(p.ws + WS_BAR) + 3500 + ph;
      volatile LAS unsigned* qword = (volatile LAS unsigned*)((LAS char*)shm + (LDS_BYTES - 32));
      bool first = lat;
      for (;;) {
        int kind, arg;
        if (first) {
          const int xcd_ = b & 7, k_ = b >> 3;
          kind = 2; arg = (xcd_ * 2 + (k_ >> 2)) * 4 + (k_ & 3); first = false;
        }
        else {
          lds_barrier();
          if (threadIdx.x == 0) qword[0] = __hip_atomic_fetch_add(qctr, 1u, __ATOMIC_RELAXED, __HIP_MEMORY_SCOPE_AGENT);
          lds_barrier();
          const int idx = (int)qword[0];
          if (idx >= nG + nB + nL + nC) break;
          if (idx < nG) { kind = 0; arg = idx; }
          else if (idx < nG + nB) { kind = 3; arg = idx - nG; }
          else if (idx < nG + nB + nL) { kind = 1; arg = idx - nG - nB; }
          else { kind = 2; arg = c0 + idx - nG - nB - nL; }
        }
        if (kind == 0) phase_gemm1a(p, H_PTR, ph, arg, 1 << 20);
        else if (kind == 3) phase_gemm1b(p, H_PTR, arg, 1 << 20, ph == NG ? 0 : 1);
        else if (kind == 1) lru_item(p, ph - 1, arg, 1, tacc);
        else {
          long long ta_ = WCLK();
          gdn_seq_item(p, ph - 1, arg, OF_PTR, OB_PTR);
          long long tb_ = WCLK();
          if (((PROBE_MASK >> 12) & 1) && arg < 64) tacc += tb_ - ta_;
        }
      }
    }
    GRID_BAR()
    TICK(4)
    if (ph <= NG) {
      const int g = ph;
      if (g > 0) phase_finalize(p, g - 1, OF_PTR, OB_PTR, ph < NG);
      if (ph < NG) {
        for (int it = blockIdx.x; it < 1280; it += gridDim.x) {
          long long ta_ = WCLK();
          if (it < 640) gdn_prep_item(p, it, tacc);
          else lru_item(p, g, it - 640, 0, tacc);
          long long tb_ = WCLK();
          if ((PROBE_MASK >> (it < 640 ? 10 : 11)) & 1) tacc += tb_ - ta_;
        }
      }
      GRID_BAR()
      TICK(3)
    }
  }
  {
    unsigned* qctr = (unsigned*)(p.ws + WS_BAR) + 3510;
    unsigned* rbcnt = (unsigned*)(p.ws + WS_BAR) + 3520;
    volatile LAS unsigned* qword = (volatile LAS unsigned*)((LAS char*)shm + (LDS_BYTES - 32));
    unsigned* tflag = (unsigned*)(p.ws + WS_BAR) + 3600;
    for (;;) {
      lds_barrier();
      if (threadIdx.x == 0) qword[0] = __hip_atomic_fetch_add(qctr, 1u, __ATOMIC_RELAXED, __HIP_MEMORY_SCOPE_AGENT);
      lds_barrier();
      const int idx = (int)qword[0];
      if (idx >= 960) break;
      if (idx < 640) {
        const int half = idx >= 320 ? 1 : 0;
        const int tile = idx - half * 320;
        if (half) {
          if (threadIdx.x == 0) {
            while (__hip_atomic_load(tflag + tile, __ATOMIC_RELAXED, __HIP_MEMORY_SCOPE_AGENT) < 1u) __builtin_amdgcn_s_sleep(2);
            __builtin_amdgcn_fence(__ATOMIC_ACQUIRE, "agent");
            asm volatile("s_waitcnt vmcnt(0)" ::: "memory");
          }
          lds_barrier();
        }
        phase_gemm3(p, tile, half);
        asm volatile("s_waitcnt vmcnt(0)" ::: "memory");
        lds_barrier();
        if (threadIdx.x == 0)
          __hip_atomic_fetch_add(half ? rbcnt + (tile >> 2) : tflag + tile, 1u, __ATOMIC_RELAXED, __HIP_MEMORY_SCOPE_AGENT);
      } else {
        const int j = idx - 640;
        if (threadIdx.x == 0) {
          while (__hip_atomic_load(rbcnt + (j >> 2), __ATOMIC_RELAXED, __HIP_MEMORY_SCOPE_AGENT) < 4u) __builtin_amdgcn_s_sleep(2);
          __builtin_amdgcn_fence(__ATOMIC_ACQUIRE, "agent");
          asm volatile("s_waitcnt vmcnt(0)" ::: "memory");
        }
        lds_barrier();
        phase_gemm4(p, j, 1 << 20);
      }
    }
  }
  GRID_BAR()
  TICK(8)
#ifdef EXTRA_SYNCS
  for (int i = 0; i < EXTRA_SYNCS; ++i) GRID_BAR()
#endif
  phase_final(p);
  TICK(9)
#if PROBE_MASK
  if (blockIdx.x == 0) {
    long long s0 = wall_clock64();
    while (wall_clock64() - s0 < tacc) {}
  }
#endif
}

extern "C" void kernel_launch(void* const* d_in, const int* in_sizes, int n_in, void* d_out, int out_size, void* d_ws,
                              size_t ws_size, hipStream_t stream) {
  static int grid_blocks = 0;
  if (grid_blocks == 0) {
    int dev = 0, cus = 0, per_cu = 0;
    hipGetDevice(&dev);
    hipDeviceGetAttribute(&cus, hipDeviceAttributeMultiprocessorCount, dev);
    if (hipFuncSetAttribute((const void*)fwd_megakernel, hipFuncAttributeMaxDynamicSharedMemorySize, LDS_BYTES) != hipSuccess)
      fprintf(stderr, "hipFuncSetAttribute failed\n");
    hipOccupancyMaxActiveBlocksPerMultiprocessor(&per_cu, (const void*)fwd_megakernel, 512, LDS_BYTES);
    if (per_cu < 1) { fprintf(stderr, "occupancy query says %d blocks/CU\n", per_cu); per_cu = 1; }
    if (per_cu > 1) per_cu = 1;
    grid_blocks = cus * per_cu;
    if (ws_size < WS_END2) fprintf(stderr, "workspace too small: %zu < %zu\n", ws_size, (size_t)WS_END);
  }
  Params p{};
  for (int i = 0; i < 37; ++i) p.in[i] = (const float*)d_in[i];
  p.out = (float*)d_out;
  p.ws = (char*)d_ws;
  if (hipMemsetAsync((char*)d_ws + WS_BAR, 0, 16384, stream) != hipSuccess) fprintf(stderr, "memset of barrier words failed\n");
  void* args[] = {&p};
  hipError_t e = hipLaunchCooperativeKernel((const void*)fwd_megakernel, dim3(grid_blocks), dim3(512), args, LDS_BYTES, stream);
  if (e != hipSuccess) fprintf(stderr, "cooperative launch failed: %s (grid %d)\n", hipGetErrorString(e), grid_blocks);
}
```
